# Optimizing an MI355X kernel written in HIP

```python
import jax, jax.numpy as jnp
from jax import lax
import numpy as np

D_MODEL = 2048
BATCH = 8
SEQ = 4096
DEPTH = 1
DEC_BATCH = 2
DEC_SEQ = 16384
PAST_LEN = 128

GRID_W = 64
HEAD_DIM = 128
ATTN_WIDTH = D_MODEL // 2
N_Q_HEADS = ATTN_WIDTH // HEAD_DIM
N_KV_HEADS = N_Q_HEADS // 4
KV_WIDTH = N_KV_HEADS * HEAD_DIM
RNN_WIDTH = D_MODEL // 2
RNN_BLOCKS = 8
RNN_BLOCK_W = RNN_WIDTH // RNN_BLOCKS
MIX_WIDTH = ATTN_WIDTH + RNN_WIDTH
IN_WIDTH = ATTN_WIDTH + 2 * KV_WIDTH + 2 * RNN_WIDTH
SPLITS = (ATTN_WIDTH, ATTN_WIDTH + KV_WIDTH, ATTN_WIDTH + 2 * KV_WIDTH,
          ATTN_WIDTH + 2 * KV_WIDTH + RNN_WIDTH)
CONV_W = 4
CONV_PAD_L = 2
CONV_PAD_R = 1
RG_C = 8.0
D_FF = 5632
Q_BLOCK = 128
ROPE_THETA = 10000.0
ROPE_PAIRS = HEAD_DIM // 4
EPS = 1e-6

kernel_name = "hymba_attn_rglru_macaron_encoder"


def rms_norm(x, g):
    xf = x.astype(jnp.float32)
    y = xf * lax.rsqrt(jnp.mean(xf * xf, axis=-1, keepdims=True) + EPS)
    return (y * g.astype(jnp.float32)).astype(x.dtype)


def swiglu(h, w_gate, w_up, w_down):
    return (jax.nn.silu(h @ w_gate) * (h @ w_up)) @ w_down


def axial_rope_tables(seq_len):
    rows = seq_len // GRID_W
    row_id = jnp.repeat(jnp.arange(rows, dtype=jnp.float32), GRID_W)
    col_id = jnp.tile(jnp.arange(GRID_W, dtype=jnp.float32), rows)
    inv_freq = ROPE_THETA ** (-jnp.arange(ROPE_PAIRS, dtype=jnp.float32) / ROPE_PAIRS)
    ang = jnp.stack([row_id[:, None] * inv_freq, col_id[:, None] * inv_freq], axis=1)
    return jnp.cos(ang), jnp.sin(ang)


def apply_axial_rope(x, cos, sin):
    B, S, H, _ = x.shape
    xr = x.astype(jnp.float32).reshape(B, S, H, 2, 2, ROPE_PAIRS)
    x1 = xr[..., 0, :]
    x2 = xr[..., 1, :]
    c = cos[None, :, None]
    s = sin[None, :, None]
    out = jnp.stack([x1 * c - x2 * s, x2 * c + x1 * s], axis=-2)
    return out.reshape(B, S, H, HEAD_DIM).astype(x.dtype)


def blocked_attention(q, k, v):
    B, S, _, _ = q.shape
    n_blk = S // Q_BLOCK
    grp = N_Q_HEADS // N_KV_HEADS
    qb = q.reshape(B, n_blk, Q_BLOCK, N_KV_HEADS, grp, HEAD_DIM).transpose(1, 0, 2, 3, 4, 5)
    scale = HEAD_DIM ** -0.5

    def one_block(q_blk):
        s = jnp.einsum('bqkgd,bskd->bkgqs', q_blk, k,
                       preferred_element_type=jnp.float32) * scale
        p = jax.nn.softmax(s, axis=-1)
        return jnp.einsum('bkgqs,bskd->bqkgd', p.astype(v.dtype), v)

    o = lax.map(one_block, qb)
    return o.transpose(1, 0, 2, 3, 4, 5).reshape(B, S, ATTN_WIDTH)


def centred_depthwise_conv(x, w, b):
    S = x.shape[1]
    xp = jnp.pad(x, ((0, 0), (CONV_PAD_L, CONV_PAD_R), (0, 0)))
    y = xp[:, 0:S] * w[0]
    for j in range(1, CONV_W):
        y = y + xp[:, j:j + S] * w[j]
    return y + b


def block_diag_linear(x, w, b):
    B, S, R = x.shape
    xb = x.reshape(B, S, RNN_BLOCKS, RNN_BLOCK_W)
    return jnp.einsum('bsnc,ncd->bsnd', xb, w).reshape(B, S, R) + b


def rg_lru(x, w_a, b_a, w_x, b_x, lam, reverse):
    r = jax.nn.sigmoid(block_diag_linear(x, w_a, b_a).astype(jnp.float32))
    i = jax.nn.sigmoid(block_diag_linear(x, w_x, b_x).astype(jnp.float32))
    log_a = -RG_C * r * jax.nn.softplus(-lam.astype(jnp.float32))
    a = jnp.exp(log_a)
    u = jnp.sqrt(-jnp.expm1(2.0 * log_a)) * (i * x.astype(jnp.float32))

    def combine(left, right):
        a_l, b_l = left
        a_r, b_r = right
        return a_l * a_r, a_r * b_l + b_r

    _, h = lax.associative_scan(combine, (a, u), reverse=reverse, axis=1)
    return h


def encoder_layer(x, g_ffn1_pre, w_ffn1_gate, w_ffn1_up, w_ffn1_down, g_ffn1_post,
                  g_mix_pre, w_in, g_q, g_k, w_conv, b_conv,
                  w_a_fwd, b_a_fwd, w_x_fwd, b_x_fwd, lam_fwd,
                  w_a_bwd, b_a_bwd, w_x_bwd, b_x_bwd, lam_bwd,
                  g_attn_out, g_rnn_out, w_out, g_mix_post,
                  g_ffn2_pre, w_ffn2_gate, w_ffn2_up, w_ffn2_down, g_ffn2_post):
    B, S, _ = x.shape
    h = rms_norm(x, g_ffn1_pre)
    x = x + 0.5 * rms_norm(swiglu(h, w_ffn1_gate, w_ffn1_up, w_ffn1_down), g_ffn1_post)

    h = rms_norm(x, g_mix_pre)
    z = h @ w_in
    q, k, v, xr, yr = jnp.split(z, SPLITS, axis=-1)

    cos, sin = axial_rope_tables(S)
    q = apply_axial_rope(rms_norm(q.reshape(B, S, N_Q_HEADS, HEAD_DIM), g_q), cos, sin)
    k = apply_axial_rope(rms_norm(k.reshape(B, S, N_KV_HEADS, HEAD_DIM), g_k), cos, sin)
    v = v.reshape(B, S, N_KV_HEADS, HEAD_DIM)
    attn = blocked_attention(q, k, v)

    xc = centred_depthwise_conv(xr, w_conv, b_conv)
    h_f = rg_lru(xc, w_a_fwd, b_a_fwd, w_x_fwd, b_x_fwd, lam_fwd, reverse=False)
    h_b = rg_lru(xc, w_a_bwd, b_a_bwd, w_x_bwd, b_x_bwd, lam_bwd, reverse=True)
    rnn = ((h_f + h_b) * jax.nn.gelu(yr.astype(jnp.float32))).astype(x.dtype)

    mixed = jnp.concatenate([rms_norm(attn, g_attn_out), rms_norm(rnn, g_rnn_out)], axis=-1)
    x = x + rms_norm(mixed @ w_out, g_mix_post)

    h = rms_norm(x, g_ffn2_pre)
    x = x + 0.5 * rms_norm(swiglu(h, w_ffn2_gate, w_ffn2_up, w_ffn2_down), g_ffn2_post)
    return x


def setup_inputs(seed: int = 0) -> dict:
    key = jax.random.key(seed)
    ks = jax.random.split(key, 40)
    f32 = jnp.float32

    def nrm(k, shape, fan_in):
        return jax.random.normal(k, shape, f32) * (fan_in ** -0.5)

    def gain(k, n):
        return 1.0 + 0.02 * jax.random.normal(k, (DEPTH, n), f32)

    def bias(k, n):
        return 0.02 * jax.random.normal(k, (DEPTH, n), f32)

    def lam(k):
        u = jax.random.uniform(k, (DEPTH, RNN_WIDTH), f32, minval=0.9, maxval=0.999)
        s = u ** (1.0 / RG_C)
        return jnp.log(s) - jnp.log1p(-s)

    bd = (DEPTH, RNN_BLOCKS, RNN_BLOCK_W, RNN_BLOCK_W)
    return {
        "x_prompt": jax.random.normal(ks[0], (BATCH, SEQ, D_MODEL), f32),
        "x_sample": jax.random.normal(ks[1], (DEC_BATCH, DEC_SEQ, D_MODEL), f32),
        "g_ffn1_pre": gain(ks[2], D_MODEL),
        "w_ffn1_gate": nrm(ks[3], (DEPTH, D_MODEL, D_FF), D_MODEL),
        "w_ffn1_up": nrm(ks[4], (DEPTH, D_MODEL, D_FF), D_MODEL),
        "w_ffn1_down": nrm(ks[5], (DEPTH, D_FF, D_MODEL), D_FF),
        "g_ffn1_post": gain(ks[6], D_MODEL),
        "g_mix_pre": gain(ks[7], D_MODEL),
        "w_in": nrm(ks[8], (DEPTH, D_MODEL, IN_WIDTH), D_MODEL),
        "g_q": gain(ks[9], HEAD_DIM),
        "g_k": gain(ks[10], HEAD_DIM),
        "w_conv": nrm(ks[11], (DEPTH, CONV_W, RNN_WIDTH), CONV_W),
        "b_conv": bias(ks[12], RNN_WIDTH),
        "w_a_fwd": nrm(ks[13], bd, RNN_BLOCK_W),
        "b_a_fwd": bias(ks[14], RNN_WIDTH),
        "w_x_fwd": nrm(ks[15], bd, RNN_BLOCK_W),
        "b_x_fwd": bias(ks[16], RNN_WIDTH),
        "lam_fwd": lam(ks[17]),
        "w_a_bwd": nrm(ks[18], bd, RNN_BLOCK_W),
        "b_a_bwd": bias(ks[19], RNN_WIDTH),
        "w_x_bwd": nrm(ks[20], bd, RNN_BLOCK_W),
        "b_x_bwd": bias(ks[21], RNN_WIDTH),
        "lam_bwd": lam(ks[22]),
        "g_attn_out": gain(ks[23], ATTN_WIDTH),
        "g_rnn_out": gain(ks[24], RNN_WIDTH),
        "w_out": nrm(ks[25], (DEPTH, MIX_WIDTH, D_MODEL), MIX_WIDTH),
        "g_mix_post": gain(ks[26], D_MODEL),
        "g_ffn2_pre": gain(ks[27], D_MODEL),
        "w_ffn2_gate": nrm(ks[28], (DEPTH, D_MODEL, D_FF), D_MODEL),
        "w_ffn2_up": nrm(ks[29], (DEPTH, D_MODEL, D_FF), D_MODEL),
        "w_ffn2_down": nrm(ks[30], (DEPTH, D_FF, D_MODEL), D_FF),
        "g_ffn2_post": gain(ks[31], D_MODEL),
    }


def reference(x_prompt, x_sample, g_ffn1_pre, w_ffn1_gate, w_ffn1_up, w_ffn1_down, g_ffn1_post,
              g_mix_pre, w_in, g_q, g_k, w_conv, b_conv,
              w_a_fwd, b_a_fwd, w_x_fwd, b_x_fwd, lam_fwd,
              w_a_bwd, b_a_bwd, w_x_bwd, b_x_bwd, lam_bwd,
              g_attn_out, g_rnn_out, w_out, g_mix_post,
              g_ffn2_pre, w_ffn2_gate, w_ffn2_up, w_ffn2_down, g_ffn2_post):
    params = (g_ffn1_pre, w_ffn1_gate, w_ffn1_up, w_ffn1_down, g_ffn1_post,
              g_mix_pre, w_in, g_q, g_k, w_conv, b_conv,
              w_a_fwd, b_a_fwd, w_x_fwd, b_x_fwd, lam_fwd,
              w_a_bwd, b_a_bwd, w_x_bwd, b_x_bwd, lam_bwd,
              g_attn_out, g_rnn_out, w_out, g_mix_post,
              g_ffn2_pre, w_ffn2_gate, w_ffn2_up, w_ffn2_down, g_ffn2_post)

    def trunk(x):
        for layer in range(DEPTH):
            x = encoder_layer(x, *[p[layer] for p in params])
        return x

    y_prompt = trunk(x_prompt)
    y_sample = trunk(x_sample)
    return (y_prompt, y_sample)
```

```cpp
#include <hip/hip_runtime.h>
#include <cstdio>
#include <cstdint>

#ifndef MK_PER_PHASE
#define MK_PER_PHASE 0
#endif

namespace pg8 {
#define PG8_LAS __attribute__((address_space(3)))
typedef unsigned short bf16_t;
typedef short bf16x8 __attribute__((ext_vector_type(8)));
typedef float f32x4 __attribute__((ext_vector_type(4)));
typedef unsigned u32x4 __attribute__((ext_vector_type(4)));
constexpr int BM = 256, BK = 64, HALF = 128, HTB = HALF * BK * 2  , STAGE_BYTES = 8 * HTB, NXCD = 8, WGM = 4;

__host__ __device__ __forceinline__ int lds_byte(int r, int c) { const int st = (r >> 4) * 2 + (c >> 5), rr = r & 15, cc = c & 31, ob = rr * 64 + cc * 2; return st * 1024 + (ob ^ (((ob >> 9) & 1) << 5)); }
__host__ __device__ __forceinline__ void stage_rc(int b, int& R, int& C) { const int st = b / 1024, sb = b % 1024, swz = sb ^ (((sb >> 9) & 1) << 5); R = (st >> 1) * 16 + swz / 64; C = (st & 1) * 32 + (swz % 64) / 2; }
__host__ __device__ __forceinline__ int perm32(int rho) { const int n = rho >> 4, i = rho & 15; return 8 * (i >> 2) + 4 * n + (i & 3); }

struct Unit { int pm, pn; };
struct Gemm { const bf16_t* A; const bf16_t* Bt; int M, N, K; };

struct StaticOrder {
    int nM, nN, nwg, G, c;
    __host__ __device__ void init(int M, int N, int G_, int c_) { nM = M / BM; nN = N / BM; nwg = nM * nN; G = G_; c = c_; }
    __host__ __device__ bool next(int i, Unit& u) const {
        const long L = (long)i * G + c; if (L >= nwg) return false;
        int wgid = (int)L; { const int q = nwg / NXCD, r = nwg % NXCD, xcd = wgid % NXCD, off = wgid / NXCD; wgid = (xcd < r ? xcd * (q + 1) : r * (q + 1) + (xcd - r) * q) + off; }
        const int nig = WGM * nN, gid = wgid / nig, fm = gid * WGM, gsz = (nM - fm) < WGM ? (nM - fm) : WGM;
        u.pm = fm + ((wgid % nig) % gsz); u.pn = (wgid % nig) / gsz; return true;
    }
    __device__ __forceinline__ void a_ready(const Unit&) const {}
    __device__ __forceinline__ void done(const Unit&) const {}
};

__device__ __forceinline__ unsigned cvt_pk_bf16(float lo, float hi) { unsigned r; asm volatile("v_cvt_pk_bf16_f32 %0, %1, %2" : "=v"(r) : "v"(lo), "v"(hi)); return r; }

struct EpiBf16 {
    static constexpr bool PERM = true, AFTER_DRAIN = false;
    bf16_t* O; int ldc; const float* rs;
    __device__ __forceinline__ void operator()(const f32x4 (&acc)[2][2][4][2], const Unit& u, int wr, int wc, int fr, int fq) const {
        const int row0 = u.pm * BM + wr * 64 + fr; const int col0 = u.pn * BM + wc * 32 + 8 * fq;
#pragma unroll
        for (int ai = 0; ai < 2; ++ai)
#pragma unroll
            for (int m = 0; m < 4; ++m) { const int row = row0 + ai * HALF + m * 16; bf16_t* rowp = O + (size_t)row * ldc + col0; const float s = rs ? rs[row] : 1.0f;
#pragma unroll
                for (int bj = 0; bj < 2; ++bj) { const f32x4 v0 = acc[ai][bj][m][0] * s, v1 = acc[ai][bj][m][1] * s;
                    u32x4 w; w.x = cvt_pk_bf16(v0[0], v0[1]); w.y = cvt_pk_bf16(v0[2], v0[3]); w.z = cvt_pk_bf16(v1[0], v1[1]); w.w = cvt_pk_bf16(v1[2], v1[3]);
                    *(u32x4*)(rowp + bj * HALF) = w; } }
    }
};
__device__ __forceinline__ float silu_mul(float g, float u) { const float e = __builtin_amdgcn_exp2f(g * -1.4426950408889634f); return g * u * __builtin_amdgcn_rcpf(1.0f + e); }
struct EpiSwiglu {
    static constexpr bool PERM = true, AFTER_DRAIN = false;
    bf16_t* O; int ldc; const float* rs;
    __device__ __forceinline__ void operator()(const f32x4 (&acc)[2][2][4][2], const Unit& u, int wr, int wc, int fr, int fq) const {
        const int row0 = u.pm * BM + wr * 64 + fr; const int col0 = u.pn * HALF + wc * 32 + 8 * fq;
#pragma unroll
        for (int ai = 0; ai < 2; ++ai)
#pragma unroll
            for (int m = 0; m < 4; ++m) { const int row = row0 + ai * HALF + m * 16; bf16_t* rowp = O + (size_t)row * ldc + col0; const float s = rs[row];
                const f32x4 g0 = acc[ai][0][m][0] * s, g1 = acc[ai][0][m][1] * s, u0 = acc[ai][1][m][0] * s, u1 = acc[ai][1][m][1] * s;
                u32x4 w; w.x = cvt_pk_bf16(silu_mul(g0[0], u0[0]), silu_mul(g0[1], u0[1])); w.y = cvt_pk_bf16(silu_mul(g0[2], u0[2]), silu_mul(g0[3], u0[3]));
                w.z = cvt_pk_bf16(silu_mul(g1[0], u1[0]), silu_mul(g1[1], u1[1])); w.w = cvt_pk_bf16(silu_mul(g1[2], u1[2]), silu_mul(g1[3], u1[3]));
                *(u32x4*)rowp = w; }
    }
};

template <class Epi, class Sched, bool ALIGN_EPI = false, bool SP2 = false>
__device__ __forceinline__ void gemm_phase(PG8_LAS unsigned char* lds, const Gemm g, const Sched& S, const Epi& E, const int tid) {
    const int wid = __builtin_amdgcn_readfirstlane(tid >> 6), lane = tid & 63, wr = wid >> 2, wc = wid & 3, fr = lane & 15, fq = lane >> 4;
    const int K = g.K, nt = K / BK;
    unsigned voffA[2], voffB[2];
#pragma unroll
    for (int i = 0; i < 2; ++i) { int R, C; stage_rc(tid * 16 + i * 8192, R, C); const int Rb = Epi::PERM ? ((R & ~31) + perm32(R & 31)) : R;
        voffA[i] = (unsigned)(R * K + C) * 2u; voffB[i] = (unsigned)(Rb * K + C) * 2u; }
    const size_t kstep = (size_t)(BK * 2);
    const size_t hstep = (size_t)HALF * K * 2;
    const size_t tstep = 2 * hstep;
    const unsigned ldsw = (unsigned)wid * 1024u;
    const int aoff = lds_byte(wr * 64 + fr, fq * 8), boff = lds_byte(wc * 32 + fr, fq * 8);
#define PG8_SA(b, h) (((b) * 2 + (h)) * HTB)
#define PG8_SB(b, h) ((4 + (b) * 2 + (h)) * HTB)
#define PG8_STAGE(bufoff, gbase, voff) do { _Pragma("unroll") for (int _i = 0; _i < 2; ++_i) \
        __builtin_amdgcn_global_load_lds((const unsigned*)((const char*)(gbase) + (voff)[_i]), (PG8_LAS unsigned*)(lds + (bufoff) + ldsw + _i * 8192), 16, 0, 0); } while (0)
#define PG8_LDA(dst, b, h) do { _Pragma("unroll") for (int m = 0; m < 4; ++m) _Pragma("unroll") for (int k = 0; k < 2; ++k) dst[m][k] = *(const PG8_LAS bf16x8*)(lds + PG8_SA(b, h) + aoff + m * 2048 + k * 1024); } while (0)
#define PG8_LDB(dst, b, h) do { _Pragma("unroll") for (int n = 0; n < 2; ++n) _Pragma("unroll") for (int k = 0; k < 2; ++k) dst[n][k] = *(const PG8_LAS bf16x8*)(lds + PG8_SB(b, h) + boff + n * 2048 + k * 1024); } while (0)
#define PG8_MMA(ai, bj, At, Bt) do { __builtin_amdgcn_s_setprio(1); _Pragma("unroll") for (int m = 0; m < 4; ++m) _Pragma("unroll") for (int n = 0; n < 2; ++n) _Pragma("unroll") for (int k = 0; k < 2; ++k) \
        acc[ai][bj][m][n] = __builtin_amdgcn_mfma_f32_16x16x32_bf16(Bt[n][k], At[m][k], acc[ai][bj][m][n], 0, 0, 0); __builtin_amdgcn_s_setprio(0); } while (0)
#define PG8_WAIT_V(n) asm volatile("s_waitcnt vmcnt(" #n ")" ::: "memory")
#define PG8_WAIT_L(n) asm volatile("s_waitcnt lgkmcnt(" #n ")" ::: "memory")
#define PG8_BAR __builtin_amdgcn_s_barrier()
#define PG8_SCHED __builtin_amdgcn_sched_barrier(0)
    Unit cur, nxt; int ui = 0;
    if (!S.next(0, cur)) return;
    f32x4 acc[2][2][4][2];
#pragma unroll
    for (int a = 0; a < 2; ++a)
#pragma unroll
        for (int b = 0; b < 2; ++b)
#pragma unroll
            for (int m = 0; m < 4; ++m)
#pragma unroll
                for (int n = 0; n < 2; ++n) acc[a][b][m][n] = (f32x4){0.f, 0.f, 0.f, 0.f};
    bf16x8 At[4][2], B0[2][2], B1[2][2];
    const char* cA = (const char*)g.A + (size_t)cur.pm * tstep; const char* cB = (const char*)g.Bt + (size_t)cur.pn * tstep;
    S.a_ready(cur);
    if constexpr (SP2) {
        PG8_STAGE(PG8_SB(0, 0), cB, voffB); PG8_STAGE(PG8_SB(0, 1), cB + hstep, voffB); PG8_STAGE(PG8_SA(0, 0), cA, voffA); PG8_STAGE(PG8_SA(0, 1), cA + hstep, voffA);
        if (wr == 1) PG8_BAR;
        PG8_WAIT_V(2); PG8_BAR;
        PG8_STAGE(PG8_SB(1, 0), cB + kstep, voffB); PG8_STAGE(PG8_SA(1, 0), cA + kstep, voffA); PG8_STAGE(PG8_SB(1, 1), cB + hstep + kstep, voffB);
        PG8_WAIT_V(6); PG8_BAR;
    } else {
        PG8_STAGE(PG8_SB(0, 0), cB, voffB); PG8_STAGE(PG8_SA(0, 0), cA, voffA); PG8_STAGE(PG8_SB(0, 1), cB + hstep, voffB); PG8_STAGE(PG8_SA(0, 1), cA + hstep, voffA);
        if (wr == 1) PG8_BAR;
        PG8_WAIT_V(4); PG8_BAR;
        PG8_STAGE(PG8_SB(1, 0), cB + kstep, voffB); PG8_STAGE(PG8_SA(1, 0), cA + kstep, voffA); PG8_STAGE(PG8_SB(1, 1), cB + hstep + kstep, voffB);
        PG8_WAIT_V(6); PG8_BAR;
    }
    for (;;) {
        const bool has_next = S.next(ui + 1, nxt);
        const char* nA = has_next ? (const char*)g.A + (size_t)nxt.pm * tstep : cA; const char* nB = has_next ? (const char*)g.Bt + (size_t)nxt.pn * tstep : cB;
        for (int t = 0; t < nt; t += 2) {
            const bool last = (t == nt - 2);
            const char* a1 = cA + (size_t)(t + 1) * kstep;
            const char* a2 = last ? nA : cA + (size_t)(t + 2) * kstep; const char* b2 = last ? nB : cB + (size_t)(t + 2) * kstep;
            const char* a3 = a2 + kstep; const char* b3 = b2 + kstep;
            if (last && has_next) S.a_ready(nxt);
            if constexpr (SP2) {
            PG8_LDB(B0, 0, 0); PG8_LDB(B1, 0, 1); PG8_SCHED; PG8_LDA(At, 0, 0); PG8_STAGE(PG8_SA(1, 1), a1 + hstep, voffA);
            PG8_WAIT_V(8); PG8_WAIT_L(0); PG8_BAR; PG8_MMA(0, 0, At, B0); PG8_MMA(0, 1, At, B1); PG8_BAR; PG8_SCHED;
            PG8_LDA(At, 0, 1); PG8_STAGE(PG8_SB(0, 0), b2, voffB); PG8_STAGE(PG8_SB(0, 1), b2 + hstep, voffB); PG8_STAGE(PG8_SA(0, 0), a2, voffA);
            PG8_WAIT_V(8); PG8_WAIT_L(0); PG8_BAR; PG8_MMA(1, 0, At, B0); PG8_MMA(1, 1, At, B1); PG8_BAR; PG8_SCHED;
            PG8_LDB(B0, 1, 0); PG8_LDB(B1, 1, 1); PG8_SCHED; PG8_LDA(At, 1, 0); PG8_STAGE(PG8_SA(0, 1), a2 + hstep, voffA);
            PG8_WAIT_V(8); PG8_WAIT_L(0); PG8_BAR; PG8_MMA(0, 0, At, B0); PG8_MMA(0, 1, At, B1); PG8_BAR; PG8_SCHED;
            PG8_LDA(At, 1, 1); PG8_STAGE(PG8_SB(1, 0), b3, voffB); PG8_STAGE(PG8_SB(1, 1), b3 + hstep, voffB); PG8_STAGE(PG8_SA(1, 0), a3, voffA);
            PG8_WAIT_V(8); PG8_WAIT_L(0); PG8_BAR; PG8_MMA(1, 0, At, B0); PG8_MMA(1, 1, At, B1); PG8_BAR; PG8_SCHED;
            } else {
            PG8_LDB(B0, 0, 0); PG8_SCHED; PG8_LDA(At, 0, 0); PG8_STAGE(PG8_SA(1, 1), a1 + hstep, voffA);
            PG8_WAIT_L(8); PG8_BAR; PG8_WAIT_L(0); PG8_MMA(0, 0, At, B0); PG8_BAR; PG8_SCHED;
            PG8_LDB(B1, 0, 1); PG8_STAGE(PG8_SB(0, 0), b2, voffB);
            PG8_BAR; PG8_WAIT_L(0); PG8_MMA(0, 1, At, B1); PG8_BAR;
            PG8_LDA(At, 0, 1); PG8_STAGE(PG8_SA(0, 0), a2, voffA);
            PG8_BAR; PG8_WAIT_L(0); PG8_MMA(1, 0, At, B0); PG8_BAR; PG8_SCHED;
            PG8_STAGE(PG8_SB(0, 1), b2 + hstep, voffB);
            PG8_WAIT_V(6); PG8_BAR; PG8_MMA(1, 1, At, B1); PG8_BAR;
            PG8_LDB(B0, 1, 0); PG8_SCHED; PG8_LDA(At, 1, 0); PG8_STAGE(PG8_SA(0, 1), a2 + hstep, voffA);
            PG8_WAIT_L(8); PG8_BAR; PG8_WAIT_L(0); PG8_MMA(0, 0, At, B0); PG8_BAR; PG8_SCHED;
            PG8_LDB(B1, 1, 1); PG8_STAGE(PG8_SB(1, 0), b3, voffB);
            PG8_BAR; PG8_WAIT_L(0); PG8_MMA(0, 1, At, B1); PG8_BAR;
            PG8_LDA(At, 1, 1); PG8_STAGE(PG8_SA(1, 0), a3, voffA);
            PG8_BAR; PG8_WAIT_L(0); PG8_MMA(1, 0, At, B0); PG8_BAR; PG8_SCHED;
            PG8_STAGE(PG8_SB(1, 1), b3 + hstep, voffB);
            PG8_WAIT_V(6); PG8_BAR; PG8_MMA(1, 1, At, B1); PG8_BAR;
            }
        }
        if constexpr (ALIGN_EPI) { if (wr == 0) PG8_BAR; }
        E(acc, cur, wr, wc, fr, fq); S.done(cur);
        if (!has_next) break;
#pragma unroll
        for (int a = 0; a < 2; ++a)
#pragma unroll
            for (int b = 0; b < 2; ++b)
#pragma unroll
                for (int m = 0; m < 4; ++m)
#pragma unroll
                    for (int n = 0; n < 2; ++n) acc[a][b][m][n] = (f32x4){0.f, 0.f, 0.f, 0.f};
        cur = nxt; cA = nA; cB = nB; ++ui;
        if constexpr (ALIGN_EPI) { if (wr == 1) PG8_BAR; }
    }
    PG8_WAIT_V(0);
    if constexpr (!ALIGN_EPI) { if (wr == 0) PG8_BAR; }
    PG8_BAR;
#undef PG8_SA
#undef PG8_SB
#undef PG8_STAGE
#undef PG8_LDA
#undef PG8_LDB
#undef PG8_MMA
#undef PG8_WAIT_V
#undef PG8_WAIT_L
#undef PG8_BAR
#undef PG8_SCHED
}
}

namespace att {
typedef unsigned short bf16;
constexpr int D = 128, NW = 8, QBLK = 32, KVBLK = 64;
constexpr float SCALE = 0.088388347648318440f;
constexpr float THR = 8.f;
#ifndef ATT_MFMA16
#define ATT_MFMA16 1
#endif
#ifndef ATT_RING
#define ATT_RING 1
#endif
#ifndef ATT_SDEPTH_FIX
#define ATT_SDEPTH_FIX 2
#endif
constexpr int LDQ = 3584, LDK = 3584, LDO = 3584;
constexpr size_t SHM_V = KVBLK * D * 2, SHM_K = KVBLK * D * 2, SHM_ATTN = 2 * SHM_V + 2 * SHM_K + NW * 64 * 4;
using bf16x8 = __attribute__((ext_vector_type(8))) short;
using s16x4  = __attribute__((ext_vector_type(4))) short;
using f32x16 = __attribute__((ext_vector_type(16))) float;
using u32x4  = __attribute__((ext_vector_type(4))) unsigned;
using f32x4  = __attribute__((ext_vector_type(4))) float;
#define KSWZ(row, colB) ((row) * 256 + ((colB) ^ (((row) & 15) << 4)))
#define SBAR() __builtin_amdgcn_sched_barrier(0)
__device__ __forceinline__ int crow(int r, int hi) { return (r & 3) + 8 * (r >> 2) + 4 * hi; }
__device__ __forceinline__ unsigned cvtpk(float lo, float hi) { unsigned r; asm volatile("v_cvt_pk_bf16_f32 %0, %1, %2" : "=v"(r) : "v"(lo), "v"(hi)); return r; }

template <bool FIXM>
__device__ __forceinline__ void partialSM(f32x16& p0, f32x16& p1, float& m_reg, float& mn, float& alpha) {
  constexpr float C = SCALE * 1.4426950408889634f;
  if constexpr (FIXM) { alpha = 1.f;
    return; }
  float pmax = p0[0];
#pragma unroll
  for (int r = 1; r < 16; ++r) pmax = fmaxf(pmax, p0[r]);
#pragma unroll
  for (int r = 0; r < 16; ++r) pmax = fmaxf(pmax, p1[r]);
  { auto rr = __builtin_amdgcn_permlane32_swap(__float_as_uint(pmax), __float_as_uint(pmax), false, false);
    pmax = fmaxf(__uint_as_float(rr[0]), __uint_as_float(rr[1])); }
  if (__builtin_expect(__all(pmax - m_reg <= THR / SCALE), 1)) { mn = m_reg; alpha = 1.f; }
  else { mn = fmaxf(m_reg, pmax); alpha = __builtin_amdgcn_exp2f((m_reg - mn) * C); m_reg = mn; }
  float mnC = -mn * C;
#pragma unroll
  for (int r = 0; r < 16; ++r) p0[r] = fmaf(p0[r], C, mnC);
#pragma unroll
  for (int r = 0; r < 16; ++r) p1[r] = fmaf(p1[r], C, mnC);
#pragma unroll
  for (int r = 0; r < 16; ++r) p0[r] = __builtin_amdgcn_exp2f(p0[r]);
}
template <bool FIXM, bool P0DONE = false>
__device__ __forceinline__ void finishSM(f32x16& p0, f32x16& p1, float alpha, float& l_reg, bf16x8& pa0, bf16x8& pa1, bf16x8& pa2, bf16x8& pa3) {
  if constexpr (FIXM && !P0DONE) {
#pragma unroll
    for (int r = 0; r < 16; ++r) p0[r] = __builtin_amdgcn_exp2f(p0[r]); }
#pragma unroll
  for (int r = 0; r < 16; ++r) p1[r] = __builtin_amdgcn_exp2f(p1[r]);
  float ps = 0;
#pragma unroll
  for (int r = 0; r < 16; ++r) ps += p0[r];
#pragma unroll
  for (int r = 0; r < 16; ++r) ps += p1[r];
  { auto rr = __builtin_amdgcn_permlane32_swap(__float_as_uint(ps), __float_as_uint(ps), false, false);
    ps = __uint_as_float(rr[0]) + __uint_as_float(rr[1]); }
  l_reg = l_reg * alpha + ps;
#define PK4(P, BASE, OUT) do { unsigned a0 = cvtpk(P[BASE + 0], P[BASE + 1]), a1 = cvtpk(P[BASE + 2], P[BASE + 3]);   \
    unsigned b0 = cvtpk(P[BASE + 4], P[BASE + 5]), b1 = cvtpk(P[BASE + 6], P[BASE + 7]);                              \
    auto r0 = __builtin_amdgcn_permlane32_swap(a0, b0, false, false); auto r1 = __builtin_amdgcn_permlane32_swap(a1, b1, false, false); \
    u32x4 w = {r0[0], r1[0], r0[1], r1[1]}; OUT = *reinterpret_cast<bf16x8*>(&w); } while (0)
  PK4(p0, 0, pa0); PK4(p0, 8, pa1); PK4(p1, 0, pa2); PK4(p1, 8, pa3);
#undef PK4
}
__device__ __forceinline__ void qkt(f32x16& p0, f32x16& p1, const bf16* Ks, const bf16x8* qr, int r32, int hi) {
  p0 = f32x16{}; p1 = f32x16{};
#pragma unroll
  for (int d0 = 0; d0 < 8; ++d0) { int cb = (d0 * 16 + hi * 8) * 2;
    bf16x8 b0 = *reinterpret_cast<const bf16x8*>((const char*)Ks + KSWZ(r32, cb));
    bf16x8 b1 = *reinterpret_cast<const bf16x8*>((const char*)Ks + KSWZ(32 + r32, cb));
    p0 = __builtin_amdgcn_mfma_f32_32x32x16_bf16(b0, qr[d0], p0, 0, 0, 0);
    p1 = __builtin_amdgcn_mfma_f32_32x32x16_bf16(b1, qr[d0], p1, 0, 0, 0); }
}
__device__ __forceinline__ int v_st(int k, int c) { const int kk = (k & ~0xC) | ((k & 4) << 1) | ((k & 8) >> 1); return ((kk >> 3) * 4 + (c >> 5)) * 512 + ((kk & 7) * 32 + (c & 31)) * 2; }
__device__ __forceinline__ int v_rd_base(int lane) { return ((lane & 3) << 3) | (((lane >> 2) & 3) << 6) | (((lane >> 4) & 1) << 5) | (((lane >> 5) & 1) << 8); }
constexpr int v_rd_off(int d0, int ks, int half) { return d0 * 512 + ks * 4096 + half * 2048; }
template <int OFF> __device__ __forceinline__ s16x4 tr_read(int vb) {
  s16x4 r; asm volatile("ds_read_b64_tr_b16 %0, %1 offset:%2" : "=&v"(r) : "v"(vb), "i"(OFF) : "memory"); return r;
}
template <int D0> __device__ __forceinline__ void pv_one(f32x16& od, int vb, bf16x8 pa0, bf16x8 pa1, bf16x8 pa2, bf16x8 pa3) {
  const s16x4 l0 = tr_read<v_rd_off(D0, 0, 0)>(vb), h0 = tr_read<v_rd_off(D0, 0, 1)>(vb), l1 = tr_read<v_rd_off(D0, 1, 0)>(vb), h1 = tr_read<v_rd_off(D0, 1, 1)>(vb);
  const s16x4 l2 = tr_read<v_rd_off(D0, 2, 0)>(vb), h2 = tr_read<v_rd_off(D0, 2, 1)>(vb), l3 = tr_read<v_rd_off(D0, 3, 0)>(vb), h3 = tr_read<v_rd_off(D0, 3, 1)>(vb);
  asm volatile("s_waitcnt lgkmcnt(0)" ::: "memory"); SBAR();
#define PK(L, H) (bf16x8){L[0], L[1], L[2], L[3], H[0], H[1], H[2], H[3]}
  od = __builtin_amdgcn_mfma_f32_32x32x16_bf16(pa0, PK(l0, h0), od, 0, 0, 0);
  od = __builtin_amdgcn_mfma_f32_32x32x16_bf16(pa1, PK(l1, h1), od, 0, 0, 0);
  od = __builtin_amdgcn_mfma_f32_32x32x16_bf16(pa2, PK(l2, h2), od, 0, 0, 0);
  od = __builtin_amdgcn_mfma_f32_32x32x16_bf16(pa3, PK(l3, h3), od, 0, 0, 0);
#undef PK
}
template <int D0> __device__ __forceinline__ void pv_one_x(f32x16& od, int vb, bf16x8 pa0, bf16x8 pa1, bf16x8 pa2, bf16x8 pa3, f32x16& px) {
  const s16x4 l0 = tr_read<v_rd_off(D0, 0, 0)>(vb), h0 = tr_read<v_rd_off(D0, 0, 1)>(vb), l1 = tr_read<v_rd_off(D0, 1, 0)>(vb), h1 = tr_read<v_rd_off(D0, 1, 1)>(vb);
  const s16x4 l2 = tr_read<v_rd_off(D0, 2, 0)>(vb), h2 = tr_read<v_rd_off(D0, 2, 1)>(vb), l3 = tr_read<v_rd_off(D0, 3, 0)>(vb), h3 = tr_read<v_rd_off(D0, 3, 1)>(vb);
  asm volatile("s_waitcnt lgkmcnt(0)" ::: "memory"); SBAR();
#define PK(L, H) (bf16x8){L[0], L[1], L[2], L[3], H[0], H[1], H[2], H[3]}
  od = __builtin_amdgcn_mfma_f32_32x32x16_bf16(pa0, PK(l0, h0), od, 0, 0, 0); px[4 * D0 + 0] = __builtin_amdgcn_exp2f(px[4 * D0 + 0]);
  od = __builtin_amdgcn_mfma_f32_32x32x16_bf16(pa1, PK(l1, h1), od, 0, 0, 0); px[4 * D0 + 1] = __builtin_amdgcn_exp2f(px[4 * D0 + 1]);
  od = __builtin_amdgcn_mfma_f32_32x32x16_bf16(pa2, PK(l2, h2), od, 0, 0, 0); px[4 * D0 + 2] = __builtin_amdgcn_exp2f(px[4 * D0 + 2]);
  od = __builtin_amdgcn_mfma_f32_32x32x16_bf16(pa3, PK(l3, h3), od, 0, 0, 0); px[4 * D0 + 3] = __builtin_amdgcn_exp2f(px[4 * D0 + 3]);
#undef PK
}
__device__ __forceinline__ void pv_d0_x(f32x16* o, int vb, bf16x8 pa0, bf16x8 pa1, bf16x8 pa2, bf16x8 pa3, f32x16& px) {
  pv_one_x<0>(o[0], vb, pa0, pa1, pa2, pa3, px); pv_one_x<1>(o[1], vb, pa0, pa1, pa2, pa3, px); pv_one_x<2>(o[2], vb, pa0, pa1, pa2, pa3, px); pv_one_x<3>(o[3], vb, pa0, pa1, pa2, pa3, px);
}
__device__ __forceinline__ void pv_d0(f32x16* o, int vb, bf16x8 pa0, bf16x8 pa1, bf16x8 pa2, bf16x8 pa3) {
  pv_one<0>(o[0], vb, pa0, pa1, pa2, pa3); pv_one<1>(o[1], vb, pa0, pa1, pa2, pa3); pv_one<2>(o[2], vb, pa0, pa1, pa2, pa3); pv_one<3>(o[3], vb, pa0, pa1, pa2, pa3);
}
__device__ __forceinline__ unsigned short f2bf_rne(float f) { unsigned u = __float_as_uint(f); u += 0x7FFFu + ((u >> 16) & 1u); return (unsigned short)(u >> 16); }

#ifndef ATT_SPLITX
#define ATT_SPLITX 0
#endif
#ifndef ATT_STAGGER
#define ATT_STAGGER 0
#endif
template <bool FIXM, int NTT>
__device__ __forceinline__ void attn_unit(const bf16* Qb, const bf16* Kh, const bf16* Vh, bf16* Ob, int seq, char* lds, PG8_LAS unsigned char* ldsl, const int tid, const float mfix,
                                          const float* gqp, const float* tab, const int t0, const float qmul) {
  const int wid = tid >> 6, lane = tid & 63, r32 = lane & 31, hi = lane >> 5;
  constexpr bool RING = FIXM && ATT_RING;
  constexpr int NB = RING ? 3 : 2;
  static_assert(!RING || (NTT % 2 == 0 && (NTT - 1) % 6 == 3), "ring loop: the tile count must leave exactly three steps after the six-step body");
  bf16* V_lds = (bf16*)(RING ? lds + NB * SHM_K : lds); bf16* K_lds = (bf16*)(RING ? lds : lds + NB * SHM_V);
  float* ws = (float*)(lds + NB * SHM_V + NB * SHM_K) + wid * 64; float* li_l = ws; float* al_l = ws + 32;
  float m_reg = FIXM ? mfix : -1e30f, l_reg = 0; f32x16 o[4] = {}; bf16x8 qr[8];
  const bf16* Qw = Qb + (long)(wid * QBLK + r32) * LDQ + hi * 8;
#pragma unroll
  for (int d0 = 0; d0 < 8; ++d0) qr[d0] = *reinterpret_cast<const bf16x8*>(Qw + d0 * 16);
  if constexpr (FIXM) {
    float qf[8][8]; float ss = 0.f;
#pragma unroll
    for (int d0 = 0; d0 < 8; ++d0) { const u32x4 w = __builtin_bit_cast(u32x4, qr[d0]);
      qf[d0][0] = __uint_as_float(w.x << 16); qf[d0][1] = __uint_as_float(w.x & 0xffff0000u); qf[d0][2] = __uint_as_float(w.y << 16); qf[d0][3] = __uint_as_float(w.y & 0xffff0000u);
      qf[d0][4] = __uint_as_float(w.z << 16); qf[d0][5] = __uint_as_float(w.z & 0xffff0000u); qf[d0][6] = __uint_as_float(w.w << 16); qf[d0][7] = __uint_as_float(w.w & 0xffff0000u);
#pragma unroll
      for (int j = 0; j < 8; ++j) ss += qf[d0][j] * qf[d0][j]; }
    { auto rr = __builtin_amdgcn_permlane32_swap(__float_as_uint(ss), __float_as_uint(ss), false, false); ss = __uint_as_float(rr[0]) + __uint_as_float(rr[1]); }
    const float rs = __builtin_amdgcn_rsqf(ss * (1.0f / 128) + 1e-6f) * qmul;
    const int t = t0 + wid * QBLK + r32;
#pragma unroll
    for (int d0 = 0; d0 < 8; ++d0) { const float* gp = gqp + 16 * d0 + 8 * hi; const float4 g0 = *reinterpret_cast<const float4*>(gp), g1 = *reinterpret_cast<const float4*>(gp + 4);
      qf[d0][0] *= rs * g0.x; qf[d0][1] *= rs * g0.y; qf[d0][2] *= rs * g0.z; qf[d0][3] *= rs * g0.w; qf[d0][4] *= rs * g1.x; qf[d0][5] *= rs * g1.y; qf[d0][6] *= rs * g1.z; qf[d0][7] *= rs * g1.w; }
#pragma unroll
    for (int ax = 0; ax < 2; ++ax) { const int pos = ax ? (t & 63) : (t >> 6);
#pragma unroll
      for (int b = 0; b < 2; ++b) { const int da = 4 * ax + b, db = da + 2;
        const float4* tp = reinterpret_cast<const float4*>(tab + (size_t)(pos * 32 + 16 * b + 8 * hi) * 2);
#pragma unroll
        for (int j2 = 0; j2 < 4; ++j2) { const float4 cs = tp[j2];
          { const float x1 = qf[da][2 * j2], x2 = qf[db][2 * j2]; qf[da][2 * j2] = x1 * cs.x - x2 * cs.y; qf[db][2 * j2] = x2 * cs.x + x1 * cs.y; }
          { const float x1 = qf[da][2 * j2 + 1], x2 = qf[db][2 * j2 + 1]; qf[da][2 * j2 + 1] = x1 * cs.z - x2 * cs.w; qf[db][2 * j2 + 1] = x2 * cs.z + x1 * cs.w; } } } }
#pragma unroll
    for (int d0 = 0; d0 < 8; ++d0) { u32x4 w = {cvtpk(qf[d0][0], qf[d0][1]), cvtpk(qf[d0][2], qf[d0][3]), cvtpk(qf[d0][4], qf[d0][5]), cvtpk(qf[d0][6], qf[d0][7])}; qr[d0] = __builtin_bit_cast(bf16x8, w); }
  }
  int sr = tid >> 4; asm volatile("" : "+v"(sr));
  const int sc = (tid & 15) * 8, vst0 = v_st(sr, sc), vst1 = v_st(32 + sr, sc);
  const int vb0 = (int)(uintptr_t)V_lds + v_rd_base(lane);
  f32x16 pA0, pA1, pB0, pB1; bf16x8 pa0, pa1, pa2, pa3;
  if constexpr (RING) {
    const int widu = __builtin_amdgcn_readfirstlane(wid);
    const int krow = 4 * widu + (lane >> 4), kk_ = ((widu >> 1) << 3) | ((lane >> 2) & 7), vkey = (kk_ & ~0xC) | ((kk_ & 4) << 1) | ((kk_ & 8) >> 1);
    const unsigned koff = (unsigned)(krow * LDK + (((lane & 15) ^ (krow & 15)) << 3)) * 2u;
    const unsigned voff = (unsigned)(vkey * LDK + ((((2 * widu + (lane >> 5)) & 3) << 5) + ((lane & 3) << 3)) + (int)(Vh - Kh)) * 2u;
    PG8_LAS unsigned char* const dK = ldsl + widu * 1024; PG8_LAS unsigned char* const dV = ldsl + 3 * SHM_K + widu * 1024;
#define RDMA(b, k0) do { const char* g_ = (const char*)(Kh + (long)(k0) * LDK); const char* g2_ = g_ + 64L * LDK; \
    __builtin_amdgcn_global_load_lds((const unsigned*)(g_ + koff), (PG8_LAS unsigned*)(dK + (b) * SHM_K), 16, 0, 0); \
    __builtin_amdgcn_global_load_lds((const unsigned*)(g2_ + koff), (PG8_LAS unsigned*)(dK + (b) * SHM_K + 8192), 16, 0, 0); \
    __builtin_amdgcn_global_load_lds((const unsigned*)(g_ + voff), (PG8_LAS unsigned*)(dV + (b) * SHM_V), 16, 0, 0); \
    __builtin_amdgcn_global_load_lds((const unsigned*)(g2_ + voff), (PG8_LAS unsigned*)(dV + (b) * SHM_V + 8192), 16, 0, 0); } while (0)
#define RSYNC() do { asm volatile("s_waitcnt vmcnt(0)" ::: "memory"); __syncthreads(); } while (0)
#if ATT_SPLITX
#define RFIN(PO0, PO1) finishSM<true, true>(PO0, PO1, 1.f, l_reg, pa0, pa1, pa2, pa3)
#define RPV(VP, PN0) pv_d0_x(o, vb0 + (VP) * (int)SHM_V, pa0, pa1, pa2, pa3, PN0)
#else
#define RFIN(PO0, PO1) finishSM<true>(PO0, PO1, 1.f, l_reg, pa0, pa1, pa2, pa3)
#define RPV(VP, PN0) pv_d0(o, vb0 + (VP) * (int)SHM_V, pa0, pa1, pa2, pa3)
#endif
#define RSTEP(PN0, PN1, PO0, PO1, KC, VP, WN, WR, T) do { \
    if (WR) { if (!ATT_STAGGER || early) RDMA(WN, ((T) + 1) * KVBLK); } \
    SBAR(); qkt(PN0, PN1, (bf16*)((char*)K_lds + (KC) * SHM_K), qr, r32, hi); \
    RFIN(PO0, PO1); SBAR(); \
    if (WR) { if (ATT_STAGGER && !early) RDMA(WN, ((T) + 1) * KVBLK); } SBAR(); \
    RPV(VP, PN0); \
    RSYNC(); } while (0)
    const bool early = widu < 4;
    __syncthreads();
    RDMA(0, 0); RSYNC();
    RDMA(1, KVBLK); SBAR(); qkt(pA0, pA1, K_lds, qr, r32, hi);
#if ATT_SPLITX
    _Pragma("unroll") for (int r = 0; r < 16; ++r) pA0[r] = __builtin_amdgcn_exp2f(pA0[r]);
#endif
    RSYNC();
    for (int t = 1; t < NTT - 3; t += 6) {
      RSTEP(pB0, pB1, pA0, pA1, 1, 0, 2, true, t);
      RSTEP(pA0, pA1, pB0, pB1, 2, 1, 0, true, t + 1);
      RSTEP(pB0, pB1, pA0, pA1, 0, 2, 1, true, t + 2);
      RSTEP(pA0, pA1, pB0, pB1, 1, 0, 2, true, t + 3);
      RSTEP(pB0, pB1, pA0, pA1, 2, 1, 0, true, t + 4);
      RSTEP(pA0, pA1, pB0, pB1, 0, 2, 1, true, t + 5);
    }
    RSTEP(pB0, pB1, pA0, pA1, 1, 0, 2, true, NTT - 3);
    RSTEP(pA0, pA1, pB0, pB1, 2, 1, 0, true, NTT - 2);
    RSTEP(pB0, pB1, pA0, pA1, 0, 2, 1, false, NTT - 1);
    RFIN(pB0, pB1); SBAR();
    pv_d0(o, vb0, pa0, pa1, pa2, pa3);
#undef RDMA
#undef RSYNC
#undef RSTEP
#undef RFIN
#undef RPV
  } else {
  constexpr int SDEPTH = FIXM ? ATT_SDEPTH_FIX : 2;
  struct { bf16x8 vs0, vs1, ks0, ks1; } sr_[SDEPTH];
#define SLOAD(i, k0) do { sr_[i].vs0 = *reinterpret_cast<const bf16x8*>(&Vh[(long)((k0) + sr) * LDK + sc]); sr_[i].vs1 = *reinterpret_cast<const bf16x8*>(&Vh[(long)((k0) + 32 + sr) * LDK + sc]); \
    sr_[i].ks0 = *reinterpret_cast<const bf16x8*>(&Kh[(long)((k0) + sr) * LDK + sc]); sr_[i].ks1 = *reinterpret_cast<const bf16x8*>(&Kh[(long)((k0) + 32 + sr) * LDK + sc]); } while (0)
#define SWRITE(b, i) do { *(bf16x8*)((char*)V_lds + (b) * SHM_V + vst0) = sr_[i].vs0;          \
    *(bf16x8*)((char*)V_lds + (b) * SHM_V + vst1) = sr_[i].vs1; int kc = sc * 2;               \
    *(bf16x8*)((char*)K_lds + (b) * SHM_K + KSWZ(sr, kc)) = sr_[i].ks0;                       \
    *(bf16x8*)((char*)K_lds + (b) * SHM_K + KSWZ(32 + sr, kc)) = sr_[i].ks1; } while (0)
#define SWAIT() do { if constexpr (SDEPTH == 2) asm volatile("s_waitcnt vmcnt(4)" ::: "memory"); else asm volatile("s_waitcnt vmcnt(0)" ::: "memory"); } while (0)
#define RESC(a) do { if (!FIXM && __any((a) < 1.f)) { if (hi == 0) al_l[r32] = (a); asm volatile("s_waitcnt lgkmcnt(0)" ::: "memory"); \
    _Pragma("unroll") for (int d = 0; d < 4; ++d) _Pragma("unroll") for (int r = 0; r < 16; ++r) o[d][r] *= al_l[crow(r, hi)]; } } while (0)
  float mnA, mnB, alA, alB; const int NT = seq / KVBLK;
  constexpr int SE = 0, SO = SDEPTH - 1;
  SLOAD(SE, 0); asm volatile("s_waitcnt vmcnt(0)" ::: "memory"); SWRITE(0, SE); __syncthreads();
  qkt(pA0, pA1, K_lds, qr, r32, hi); partialSM<FIXM>(pA0, pA1, m_reg, mnA, alA);
  SLOAD(SO, KVBLK); if constexpr (SDEPTH == 2) { if (2 < NT) SLOAD(SE, 2 * KVBLK); }
  SWAIT(); SWRITE(1, SO); __syncthreads();
  for (int j = 1; j + 1 < NT; j += 2) {
    SBAR(); qkt(pB0, pB1, (bf16*)((char*)K_lds + SHM_K), qr, r32, hi);
    finishSM<FIXM>(pA0, pA1, alA, l_reg, pa0, pa1, pa2, pa3); SBAR();
    SLOAD(SO, (j + SDEPTH) * KVBLK); SBAR();
    pv_d0(o, vb0, pa0, pa1, pa2, pa3); partialSM<FIXM>(pB0, pB1, m_reg, mnB, alB);
    __syncthreads(); SWAIT(); SWRITE(0, SE);
    RESC(alB); __syncthreads();
    SBAR(); qkt(pA0, pA1, K_lds, qr, r32, hi);
    finishSM<FIXM>(pB0, pB1, alB, l_reg, pa0, pa1, pa2, pa3); SBAR();
    if (SDEPTH == 1 || j + 3 < NT) SLOAD(SE, (j + 1 + SDEPTH) * KVBLK); SBAR();
    pv_d0(o, vb0 + (int)SHM_V, pa0, pa1, pa2, pa3); partialSM<FIXM>(pA0, pA1, m_reg, mnA, alA);
    __syncthreads(); SWAIT(); SWRITE(1, SO);
    RESC(alA); __syncthreads();
  }
  SBAR(); qkt(pB0, pB1, (bf16*)((char*)K_lds + SHM_K), qr, r32, hi);
  finishSM<FIXM>(pA0, pA1, alA, l_reg, pa0, pa1, pa2, pa3); SBAR();
  pv_d0(o, vb0, pa0, pa1, pa2, pa3); partialSM<FIXM>(pB0, pB1, m_reg, mnB, alB);
  __syncthreads(); RESC(alB);
  finishSM<FIXM>(pB0, pB1, alB, l_reg, pa0, pa1, pa2, pa3); SBAR();
  pv_d0(o, vb0 + (int)SHM_V, pa0, pa1, pa2, pa3);
  }
  if (hi == 0) li_l[r32] = l_reg; asm volatile("s_waitcnt lgkmcnt(0)" ::: "memory");
  float rli[16];
#pragma unroll
  for (int r = 0; r < 16; ++r) rli[r] = __builtin_amdgcn_rcpf(li_l[crow(r, hi)]);
  const int odd = r32 & 1; bf16* Ow = Ob + (long)(wid * QBLK + 4 * hi + odd) * LDO + (r32 & ~1);
  asm volatile("" : "+v"(Ow));
#pragma unroll
  for (int d0 = 0; d0 < 4; ++d0)
#pragma unroll
    for (int i = 0; i < 8; ++i) { float v0 = o[d0][2 * i] * rli[2 * i], v1 = o[d0][2 * i + 1] * rli[2 * i + 1];
      asm volatile("" : "+v"(v0), "+v"(v1));
      const float send = odd ? v0 : v1;
      const float recv = __builtin_bit_cast(float, __builtin_amdgcn_update_dpp(0, __builtin_bit_cast(int, send), 0xB1, 0xF, 0xF, true));
      const unsigned w = cvtpk(odd ? recv : v0, odd ? v1 : recv);
      *(unsigned*)(Ow + (long)(((2 * i) & 3) + 8 * ((2 * i) >> 2)) * LDO + d0 * 32) = w; }
#undef SLOAD
#undef SWRITE
#undef SWAIT
#undef RESC
}

struct S16 { f32x4 t[4][2]; };
template <int OFF> __device__ __forceinline__ bf16x8 k_read(int a) { bf16x8 r; asm volatile("ds_read_b128 %0, %1 offset:%2" : "=&v"(r) : "v"(a), "i"(OFF) : "memory"); return r; }
typedef __bf16 bf16x2_n __attribute__((ext_vector_type(2))); typedef float f32x2_n __attribute__((ext_vector_type(2)));
__device__ __forceinline__ unsigned cvtpk_n(float lo, float hi) { const f32x2_n v = {lo, hi}; return __builtin_bit_cast(unsigned, __builtin_convertvector(v, bf16x2_n)); }
template <int KT> __device__ __forceinline__ void fin16_part(S16& p, float (&l)[2], bf16x8 (&pb)[2][2]) {
#pragma unroll
  for (int qt = 0; qt < 2; ++qt)
#pragma unroll
    for (int r = 0; r < 4; ++r) { p.t[KT][qt][r] = __builtin_amdgcn_exp2f(p.t[KT][qt][r]); l[qt] += p.t[KT][qt][r]; }
  if constexpr (KT & 1) {
#pragma unroll
    for (int qt = 0; qt < 2; ++qt) { const f32x4 a = p.t[KT - 1][qt], b = p.t[KT][qt];
      u32x4 w = {cvtpk_n(a[0], a[1]), cvtpk_n(a[2], a[3]), cvtpk_n(b[0], b[1]), cvtpk_n(b[2], b[3])}; pb[qt][KT >> 1] = __builtin_bit_cast(bf16x8, w); } }
}
__device__ __forceinline__ void finish16(S16& p, float (&l)[2], bf16x8 (&pb)[2][2]) { fin16_part<0>(p, l, pb); fin16_part<1>(p, l, pb); fin16_part<2>(p, l, pb); fin16_part<3>(p, l, pb); }
#define QK16_MMA(F, KS) do { _Pragma("unroll") for (int kt = 0; kt < 4; ++kt) { \
    s.t[kt][0] = __builtin_amdgcn_mfma_f32_16x16x32_bf16(F[kt], qr[0][KS], s.t[kt][0], 0, 0, 0); \
    s.t[kt][1] = __builtin_amdgcn_mfma_f32_16x16x32_bf16(F[kt], qr[1][KS], s.t[kt][1], 0, 0, 0); } } while (0)
#define QK16_RD(F, KS) do { F[0] = k_read<KC * 16384>(ka[KS]); F[1] = k_read<KC * 16384 + 4096>(ka[KS]); F[2] = k_read<KC * 16384 + 8192>(ka[KS]); F[3] = k_read<KC * 16384 + 12288>(ka[KS]); } while (0)
#define QK16_WAIT() do { asm volatile("s_waitcnt lgkmcnt(0)" ::: "memory"); SBAR(); } while (0)
template <int KC, bool FIN> __device__ __forceinline__ void qk16(S16& s, S16& po, float (&l)[2], bf16x8 (&pb)[2][2], const int (&ka)[4], const bf16x8 (&qr)[2][4]) {
  bf16x8 f0[4], f1[4];
  QK16_RD(f0, 0);
#pragma unroll
  for (int kt = 0; kt < 4; ++kt) { s.t[kt][0] = (f32x4){0.f, 0.f, 0.f, 0.f}; s.t[kt][1] = (f32x4){0.f, 0.f, 0.f, 0.f}; }
  QK16_WAIT(); QK16_RD(f1, 1); QK16_MMA(f0, 0); if constexpr (FIN) fin16_part<0>(po, l, pb);
  QK16_WAIT(); QK16_RD(f0, 2); QK16_MMA(f1, 1); if constexpr (FIN) fin16_part<1>(po, l, pb);
  QK16_WAIT(); QK16_RD(f1, 3); QK16_MMA(f0, 2); if constexpr (FIN) fin16_part<2>(po, l, pb);
  QK16_WAIT();                 QK16_MMA(f1, 3); if constexpr (FIN) fin16_part<3>(po, l, pb);
}
#undef QK16_MMA
#undef QK16_RD
#undef QK16_WAIT
template <int DT0> __device__ __forceinline__ void pv16_two(f32x4 (&o)[8][2], int vb, const bf16x8 (&pb)[2][2]) {
  const s16x4 a00 = tr_read<0 * 4096 + DT0 * 256>(vb), a01 = tr_read<1 * 4096 + DT0 * 256>(vb), a10 = tr_read<2 * 4096 + DT0 * 256>(vb), a11 = tr_read<3 * 4096 + DT0 * 256>(vb);
  const s16x4 b00 = tr_read<0 * 4096 + DT0 * 256 + 256>(vb), b01 = tr_read<1 * 4096 + DT0 * 256 + 256>(vb), b10 = tr_read<2 * 4096 + DT0 * 256 + 256>(vb), b11 = tr_read<3 * 4096 + DT0 * 256 + 256>(vb);
  asm volatile("s_waitcnt lgkmcnt(0)" ::: "memory"); SBAR();
#define PK(L, H) (bf16x8){L[0], L[1], L[2], L[3], H[0], H[1], H[2], H[3]}
  o[DT0][0] = __builtin_amdgcn_mfma_f32_16x16x32_bf16(PK(a00, a01), pb[0][0], o[DT0][0], 0, 0, 0);
  o[DT0][1] = __builtin_amdgcn_mfma_f32_16x16x32_bf16(PK(a00, a01), pb[1][0], o[DT0][1], 0, 0, 0);
  o[DT0 + 1][0] = __builtin_amdgcn_mfma_f32_16x16x32_bf16(PK(b00, b01), pb[0][0], o[DT0 + 1][0], 0, 0, 0);
  o[DT0 + 1][1] = __builtin_amdgcn_mfma_f32_16x16x32_bf16(PK(b00, b01), pb[1][0], o[DT0 + 1][1], 0, 0, 0);
  o[DT0][0] = __builtin_amdgcn_mfma_f32_16x16x32_bf16(PK(a10, a11), pb[0][1], o[DT0][0], 0, 0, 0);
  o[DT0][1] = __builtin_amdgcn_mfma_f32_16x16x32_bf16(PK(a10, a11), pb[1][1], o[DT0][1], 0, 0, 0);
  o[DT0 + 1][0] = __builtin_amdgcn_mfma_f32_16x16x32_bf16(PK(b10, b11), pb[0][1], o[DT0 + 1][0], 0, 0, 0);
  o[DT0 + 1][1] = __builtin_amdgcn_mfma_f32_16x16x32_bf16(PK(b10, b11), pb[1][1], o[DT0 + 1][1], 0, 0, 0);
#undef PK
}
__device__ __forceinline__ void pv16(f32x4 (&o)[8][2], int vb, const bf16x8 (&pb)[2][2]) { pv16_two<0>(o, vb, pb); pv16_two<2>(o, vb, pb); pv16_two<4>(o, vb, pb); pv16_two<6>(o, vb, pb); }
__device__ __forceinline__ float sum4groups(float v) {
  v += __builtin_bit_cast(float, __builtin_amdgcn_ds_swizzle(__builtin_bit_cast(int, v), 0x401F));
  auto rr = __builtin_amdgcn_permlane32_swap(__float_as_uint(v), __float_as_uint(v), false, false);
  return __uint_as_float(rr[0]) + __uint_as_float(rr[1]);
}
template <int NTT>
__device__ __forceinline__ void attn_unit16(const bf16* Qb, const bf16* Kh, const bf16* Vh, bf16* Ob, char* lds, PG8_LAS unsigned char* ldsl, const int tid,
                                            const float* gqp, const float* tab, const int t0, const float qmul) {
  static_assert(NTT % 2 == 0 && (NTT - 1) % 6 == 3, "ring loop: the tile count must leave exactly three steps after the six-step body");
  const int wid = tid >> 6, lane = tid & 63, li = lane & 15, lg = lane >> 4;
  char* const K_lds = lds;
  float l_reg[2] = {0.f, 0.f}; f32x4 o[8][2]; bf16x8 qr[2][4];
#pragma unroll
  for (int dt = 0; dt < 8; ++dt) { o[dt][0] = (f32x4){0.f, 0.f, 0.f, 0.f}; o[dt][1] = (f32x4){0.f, 0.f, 0.f, 0.f}; }
#pragma unroll
  for (int qt = 0; qt < 2; ++qt) { const bf16* Qw = Qb + (long)(wid * QBLK + 16 * qt + li) * LDQ + 8 * lg;
#pragma unroll
    for (int ks = 0; ks < 4; ++ks) qr[qt][ks] = *reinterpret_cast<const bf16x8*>(Qw + 32 * ks); }
#pragma unroll
  for (int qt = 0; qt < 2; ++qt) { float qf[4][8]; float ss = 0.f;
#pragma unroll
    for (int ks = 0; ks < 4; ++ks) { const u32x4 w = __builtin_bit_cast(u32x4, qr[qt][ks]);
      qf[ks][0] = __uint_as_float(w.x << 16); qf[ks][1] = __uint_as_float(w.x & 0xffff0000u); qf[ks][2] = __uint_as_float(w.y << 16); qf[ks][3] = __uint_as_float(w.y & 0xffff0000u);
      qf[ks][4] = __uint_as_float(w.z << 16); qf[ks][5] = __uint_as_float(w.z & 0xffff0000u); qf[ks][6] = __uint_as_float(w.w << 16); qf[ks][7] = __uint_as_float(w.w & 0xffff0000u);
#pragma unroll
      for (int j = 0; j < 8; ++j) ss += qf[ks][j] * qf[ks][j]; }
    ss = sum4groups(ss);
    const float rs = __builtin_amdgcn_rsqf(ss * (1.0f / 128) + 1e-6f) * qmul;
    const int t = t0 + wid * QBLK + 16 * qt + li;
#pragma unroll
    for (int ks = 0; ks < 4; ++ks) { const float* gp = gqp + 32 * ks + 8 * lg; const float4 g0 = *reinterpret_cast<const float4*>(gp), g1 = *reinterpret_cast<const float4*>(gp + 4);
      qf[ks][0] *= rs * g0.x; qf[ks][1] *= rs * g0.y; qf[ks][2] *= rs * g0.z; qf[ks][3] *= rs * g0.w; qf[ks][4] *= rs * g1.x; qf[ks][5] *= rs * g1.y; qf[ks][6] *= rs * g1.z; qf[ks][7] *= rs * g1.w; }
#pragma unroll
    for (int ax = 0; ax < 2; ++ax) { const int pos = ax ? (t & 63) : (t >> 6); const int da = 2 * ax, db = da + 1;
      const float4* tp = reinterpret_cast<const float4*>(tab + (size_t)(pos * 32 + 8 * lg) * 2);
#pragma unroll
      for (int j2 = 0; j2 < 4; ++j2) { const float4 cs = tp[j2];
        { const float x1 = qf[da][2 * j2], x2 = qf[db][2 * j2]; qf[da][2 * j2] = x1 * cs.x - x2 * cs.y; qf[db][2 * j2] = x2 * cs.x + x1 * cs.y; }
        { const float x1 = qf[da][2 * j2 + 1], x2 = qf[db][2 * j2 + 1]; qf[da][2 * j2 + 1] = x1 * cs.z - x2 * cs.w; qf[db][2 * j2 + 1] = x2 * cs.z + x1 * cs.w; } } }
#pragma unroll
    for (int ks = 0; ks < 4; ++ks) { u32x4 w = {cvtpk(qf[ks][0], qf[ks][1]), cvtpk(qf[ks][2], qf[ks][3]), cvtpk(qf[ks][4], qf[ks][5]), cvtpk(qf[ks][6], qf[ks][7])}; qr[qt][ks] = __builtin_bit_cast(bf16x8, w); } }
  int ka[4];
#pragma unroll
  for (int ks = 0; ks < 4; ++ks) ka[ks] = (int)(uintptr_t)K_lds + li * 256 + ((64 * ks + 16 * lg) ^ (16 * li));
  const int vb0 = (int)(uintptr_t)(lds + 3 * SHM_K) + (lg >> 1) * 2048 + (4 * (lg & 1) + ((lane >> 2) & 3)) * 32 + 8 * (lane & 3);
  S16 pA, pB; bf16x8 pb[2][2];
  const int widu = __builtin_amdgcn_readfirstlane(wid);
  const int krow = 4 * widu + (lane >> 4), vrow = 8 * (widu >> 1) + ((lane >> 1) & 7), vd = 16 * ((4 * widu + (lane >> 4)) & 7) + 8 * (lane & 1);
  const unsigned koff = (unsigned)(krow * LDK + (((lane & 15) ^ (krow & 15)) << 3)) * 2u;
  const unsigned voff = (unsigned)(vrow * LDK + vd + (int)(Vh - Kh)) * 2u;
  PG8_LAS unsigned char* const dK = ldsl + widu * 1024; PG8_LAS unsigned char* const dV = ldsl + 3 * SHM_K + widu * 1024;
#define RDMA(b, k0) do { const char* g_ = (const char*)(Kh + (long)(k0) * LDK); const char* g2_ = g_ + 64L * LDK; \
    __builtin_amdgcn_global_load_lds((const unsigned*)(g_ + koff), (PG8_LAS unsigned*)(dK + (b) * SHM_K), 16, 0, 0); \
    __builtin_amdgcn_global_load_lds((const unsigned*)(g2_ + koff), (PG8_LAS unsigned*)(dK + (b) * SHM_K + 8192), 16, 0, 0); \
    __builtin_amdgcn_global_load_lds((const unsigned*)(g_ + voff), (PG8_LAS unsigned*)(dV + (b) * SHM_V), 16, 0, 0); \
    __builtin_amdgcn_global_load_lds((const unsigned*)(g2_ + voff), (PG8_LAS unsigned*)(dV + (b) * SHM_V + 8192), 16, 0, 0); } while (0)
#define RSYNC() do { asm volatile("s_waitcnt vmcnt(0)" ::: "memory"); __syncthreads(); } while (0)
#define RSTEP(PN, PO, KC, VP, WN, WR, T) do { \
    if (WR) RDMA(WN, ((T) + 1) * KVBLK); \
    SBAR(); qk16<KC, true>(PN, PO, l_reg, pb, ka, qr); SBAR(); \
    pv16(o, vb0 + (VP) * (int)SHM_V, pb); \
    RSYNC(); } while (0)
  __syncthreads();
  RDMA(0, 0); RSYNC();
  RDMA(1, KVBLK); SBAR(); qk16<0, false>(pA, pB, l_reg, pb, ka, qr); RSYNC();
  for (int t = 1; t < NTT - 3; t += 6) {
    RSTEP(pB, pA, 1, 0, 2, true, t);
    RSTEP(pA, pB, 2, 1, 0, true, t + 1);
    RSTEP(pB, pA, 0, 2, 1, true, t + 2);
    RSTEP(pA, pB, 1, 0, 2, true, t + 3);
    RSTEP(pB, pA, 2, 1, 0, true, t + 4);
    RSTEP(pA, pB, 0, 2, 1, true, t + 5);
  }
  RSTEP(pB, pA, 1, 0, 2, true, NTT - 3);
  RSTEP(pA, pB, 2, 1, 0, true, NTT - 2);
  RSTEP(pB, pA, 0, 2, 1, false, NTT - 1);
  finish16(pB, l_reg, pb); SBAR();
  pv16(o, vb0, pb);
#undef RDMA
#undef RSYNC
#undef RSTEP
  const float rl0 = __builtin_amdgcn_rcpf(sum4groups(l_reg[0])), rl1 = __builtin_amdgcn_rcpf(sum4groups(l_reg[1]));
  bf16* Ow = Ob + (long)(wid * QBLK + li) * LDO + 4 * lg;
  asm volatile("" : "+v"(Ow));
#pragma unroll
  for (int dt = 0; dt < 8; ++dt)
#pragma unroll
    for (int qt = 0; qt < 2; ++qt) { const f32x4 v = o[dt][qt] * (qt ? rl1 : rl0);
      uint2 w; w.x = cvtpk(v[0], v[1]); w.y = cvtpk(v[2], v[3]);
      *reinterpret_cast<uint2*>(Ow + (long)(16 * qt) * LDO + 16 * dt) = w; }
}
}

constexpr int NWAVES = 8;
constexpr int DM = 2048, DFF = 5632, NGU = 2 * DFF, INW = 3584, ATTW = 1024, RNNW = 1024;
constexpr int MH = 32768;
constexpr int ZQ = 0, ZK = 1024, ZV = 1280, ZXR = 1536, ZYR = 2560;
constexpr float EPS = 1e-6f;
constexpr int LC = 256;
constexpr int NCHUNK = MH / LC;
constexpr size_t MiB = 1u << 20;
constexpr size_t WS_CTL = 0, CTL_ZERO_BYTES = 1 * MiB;
constexpr size_t WS_ROPE = 1 * MiB;
constexpr size_t WS_SUM = 2 * MiB;
constexpr size_t WS_CIN = 4 * MiB;
constexpr size_t WS_RS = 5 * MiB;
constexpr size_t WS_WGU1 = 8 * MiB, WS_WD1 = 52 * MiB, WS_WIN = 74 * MiB, WS_WOUT = 88 * MiB, WS_WGU2 = 96 * MiB, WS_WD2 = 140 * MiB;
constexpr size_t WS_XN = 162 * MiB;
constexpr size_t WS_Y = 290 * MiB;
constexpr size_t WS_H = 418 * MiB;
constexpr size_t WS_Z = WS_H, WS_HLB = WS_H + 224 * MiB, WS_PRB = WS_H + 288 * MiB;
constexpr size_t WS_HLF = WS_Y, WS_PRF = WS_Y + 64 * MiB;
constexpr size_t WS_MIX = 770 * MiB;
constexpr size_t WS_END = 898 * MiB;
static_assert(WS_WGU1 + (size_t)NGU * DM * 2 <= WS_WD1 && WS_WD1 + (size_t)DM * DFF * 2 <= WS_WIN && WS_WIN + (size_t)INW * DM * 2 <= WS_WOUT && WS_WOUT + (size_t)DM * DM * 2 <= WS_WGU2 &&
              WS_WGU2 + (size_t)NGU * DM * 2 <= WS_WD2 && WS_WD2 + (size_t)DM * DFF * 2 <= WS_XN && WS_XN + (size_t)MH * DM * 2 <= WS_Y && WS_Y + (size_t)MH * DM * 2 <= WS_H &&
              WS_H + (size_t)MH * DFF * 2 <= WS_MIX && WS_MIX + (size_t)MH * DM * 2 <= WS_END && WS_Z + (size_t)MH * INW * 2 <= WS_HLB && WS_PRB + (size_t)MH * RNNW * 2 <= WS_MIX && WS_PRF + (size_t)MH * RNNW * 2 <= WS_H, "d_ws map");
constexpr int CW_TMO = 0, CW_CODE = 1;
constexpr int CW_BAR = 4096;
constexpr int RING_OFF = 0, RING_BYTES = 131072;
constexpr int LDSCTL_OFF = RING_BYTES, MISC_OFF = LDSCTL_OFF + 320;
constexpr int LDS_BYTES = 147456;
static_assert(MISC_OFF + 128 <= LDS_BYTES, "LDS map");

#define GAS __attribute__((address_space(1)))
#define LAS __attribute__((address_space(3)))
typedef unsigned short bf16;
typedef unsigned v4u __attribute__((ext_vector_type(4)));
typedef unsigned v2u __attribute__((ext_vector_type(2)));
typedef float f32x4 __attribute__((ext_vector_type(4)));
typedef float f32x2 __attribute__((ext_vector_type(2)));
typedef float f32x16 __attribute__((ext_vector_type(16)));
typedef short bf16x8 __attribute__((ext_vector_type(8)));
typedef GAS unsigned gu32;
#define RLX_AGENT __ATOMIC_RELAXED, __HIP_MEMORY_SCOPE_AGENT
#define LDS_WAIT() asm volatile("s_waitcnt lgkmcnt(0)" ::: "memory")
#define VM_WAIT() asm volatile("s_waitcnt vmcnt(0)" ::: "memory")
__device__ __forceinline__ unsigned pk2(float lo, float hi) { unsigned r; asm volatile("v_cvt_pk_bf16_f32 %0, %1, %2" : "=v"(r) : "v"(lo), "v"(hi)); return r; }
__device__ __forceinline__ float bflo(unsigned w) { return __uint_as_float(w << 16); }
__device__ __forceinline__ float bfhi(unsigned w) { return __uint_as_float(w & 0xffff0000u); }

#define XB_TMO      128
#define XB_XCNT(j)  (256  + 64 * (j))
#define XB_XSUB(j)  (1280 + 64 * (j))
#define XB_XGEN(j)  (2304 + 64 * (j))
#define XB_TOP      3328
#define XB_TOPGEN   3392
#define XCD_BAR_WORDS 3456
#define XB_SPIN_CAP (1u << 18)
__device__ __forceinline__ unsigned xb_ld(unsigned* p)              { return __hip_atomic_load(p, __ATOMIC_RELAXED, __HIP_MEMORY_SCOPE_AGENT); }
__device__ __forceinline__ unsigned xb_add(unsigned* p, unsigned v) { return __hip_atomic_fetch_add(p, v, __ATOMIC_RELAXED, __HIP_MEMORY_SCOPE_AGENT); }
__device__ __forceinline__ unsigned xb_xcc_id() { return (unsigned)__builtin_amdgcn_s_getreg((3 << 11) | 20) & 0xFu; }
#define XB_SPIN(cond, bar) do { unsigned _sp = 0; while (cond) { __builtin_amdgcn_s_sleep(1); \
    if ((++_sp & 255u) == 0u) { if (xb_ld(&(bar)[XB_TMO])) break; if (_sp > XB_SPIN_CAP) { atomicAdd(&(bar)[XB_TMO], 1u); break; } } } } while (0)
__device__ __forceinline__ int lane_id() { return (int)__builtin_amdgcn_mbcnt_hi(~0u, __builtin_amdgcn_mbcnt_lo(~0u, 0u)); }
struct XcdBarrier { unsigned* bar; unsigned x; volatile LAS unsigned* st; int wv; };
__device__ __forceinline__ XcdBarrier xcd_barrier_post(unsigned* bar, volatile LAS unsigned* st, int wv) {
    XcdBarrier b; b.bar = bar; b.x = xb_xcc_id(); b.st = st; b.wv = wv;
    if (wv == 0 && lane_id() == 0) (void)xb_add(&bar[XB_XCNT(b.x)], 1u);
    return b;
}
__device__ __forceinline__ void xcd_barrier_complete(unsigned* bar, unsigned x, unsigned& nloc, unsigned& nx) {
    const unsigned G = gridDim.x * gridDim.y * gridDim.z;
    unsigned sum, cnt, mine, sp = 0u;
    for (;;) {
        sum = 0u; cnt = 0u; mine = 0u;
#pragma unroll
        for (unsigned j = 0; j < 16; ++j) { const unsigned c = xb_ld(&bar[XB_XCNT(j)]); sum += c; cnt += (c > 0u) ? 1u : 0u; mine = (j == x) ? c : mine; }
        if (sum == G) break;
        __builtin_amdgcn_s_sleep(1);
        if ((++sp & 255u) == 0u) { if (xb_ld(&bar[XB_TMO])) break; if (sp > XB_SPIN_CAP) { atomicAdd(&bar[XB_TMO], 1u); break; } }
    }
    nloc = mine > 0u ? mine : 1u; nx = cnt > 0u ? cnt : 1u;
}
__device__ __forceinline__ void xcd_barrier(const XcdBarrier& b) {
    asm volatile("s_waitcnt vmcnt(0)" ::: "memory");
    __syncthreads();
    if (b.wv == 0 && lane_id() == 0) {
        unsigned* bar = b.bar;
        __builtin_amdgcn_s_waitcnt(0);
        unsigned nloc = b.st[0], nx = b.st[1];
        if (nloc == 0u) { xcd_barrier_complete(bar, b.x, nloc, nx); b.st[0] = nloc; b.st[1] = nx; }
        const unsigned old = xb_add(&bar[XB_XSUB(b.x)], 1u);
        const unsigned gen = old / nloc;
        if (old + 1u == (gen + 1u) * nloc) {
            __builtin_amdgcn_fence(__ATOMIC_RELEASE, "agent");
            asm volatile("s_waitcnt vmcnt(0)" ::: "memory");
            const unsigned og = xb_add(&bar[XB_TOP], 1u);
            const unsigned tg = og / nx;
            if (og + 1u == (tg + 1u) * nx) xb_add(&bar[XB_TOPGEN], 1u);
            else XB_SPIN(xb_ld(&bar[XB_TOPGEN]) == tg, bar);
            __builtin_amdgcn_fence(__ATOMIC_ACQUIRE, "agent");
            xb_add(&bar[XB_XGEN(b.x)], 1u);
            asm volatile("s_waitcnt vmcnt(0)" ::: "memory");
        } else {
            XB_SPIN(xb_ld(&bar[XB_XGEN(b.x)]) == gen, bar);
            __builtin_amdgcn_fence(__ATOMIC_ACQUIRE, "agent");
            asm volatile("s_waitcnt vmcnt(0)" ::: "memory");
        }
    }
    __syncthreads();
}

struct Args { unsigned long long in[32]; unsigned long long out, ws; int ph_lo, ph_hi; };
typedef const __attribute__((address_space(4))) Args* ArgP;
__device__ __forceinline__ ArgP argp() { ArgP p = (ArgP)__builtin_amdgcn_kernarg_segment_ptr(); asm volatile("" : "+s"(p)); return p; }
__device__ __forceinline__ const float* inp(ArgP A, int k) { return (const float*)(const GAS float*)A->in[k]; }
__device__ __forceinline__ float* outp(ArgP A) { return (float*)(GAS float*)A->out; }
template <class T> __device__ __forceinline__ T* wsp(ArgP A, size_t off) { return (T*)(GAS T*)(A->ws + off); }
struct Frame {
    LAS unsigned char* lds;
    int tid, lane, wave;
    int bid, G;
    int gw, NGW;
};
template <int TAG = 0> __device__ __forceinline__ Frame mkframe(unsigned char* lds, int wv) {
    Frame F; F.lds = (LAS unsigned char*)lds;
    int t; asm volatile("v_mbcnt_lo_u32_b32 %0, -1, 0\n\tv_mbcnt_hi_u32_b32 %0, -1, %0\n\tv_lshl_add_u32 %0, %1, 6, %0 ; frame %2" : "=&v"(t) : "s"(wv), "i"(TAG));
    int b = blockIdx.x; asm volatile("; frame %1" : "+s"(b) : "i"(TAG)); int g = gridDim.x; asm volatile("; frame %1" : "+s"(g) : "i"(TAG));
    F.tid = t; F.lane = t & 63; F.wave = __builtin_amdgcn_readfirstlane(t >> 6); F.bid = b; F.G = g; F.gw = b * NWAVES + F.wave; F.NGW = g * NWAVES;
    return F;
}
__device__ __forceinline__ float wave_sum(float v) {
    v += __builtin_bit_cast(float, __builtin_amdgcn_update_dpp(0, __builtin_bit_cast(int, v), 0xB1, 0xF, 0xF, true));
    v += __builtin_bit_cast(float, __builtin_amdgcn_update_dpp(0, __builtin_bit_cast(int, v), 0x4E, 0xF, 0xF, true));
    v += __builtin_bit_cast(float, __builtin_amdgcn_update_dpp(0, __builtin_bit_cast(int, v), 0x141, 0xF, 0xF, true));
    v += __builtin_bit_cast(float, __builtin_amdgcn_update_dpp(0, __builtin_bit_cast(int, v), 0x140, 0xF, 0xF, true));
    const int iv = __builtin_bit_cast(int, v);
    return (__builtin_bit_cast(float, __builtin_amdgcn_readlane(iv, 0)) + __builtin_bit_cast(float, __builtin_amdgcn_readlane(iv, 16))) +
           (__builtin_bit_cast(float, __builtin_amdgcn_readlane(iv, 32)) + __builtin_bit_cast(float, __builtin_amdgcn_readlane(iv, 48)));
}
__device__ __forceinline__ float wave_max(float v) {
    v = fmaxf(v, __builtin_bit_cast(float, __builtin_amdgcn_update_dpp(0, __builtin_bit_cast(int, v), 0xB1, 0xF, 0xF, true)));
    v = fmaxf(v, __builtin_bit_cast(float, __builtin_amdgcn_update_dpp(0, __builtin_bit_cast(int, v), 0x4E, 0xF, 0xF, true)));
    v = fmaxf(v, __builtin_bit_cast(float, __builtin_amdgcn_update_dpp(0, __builtin_bit_cast(int, v), 0x141, 0xF, 0xF, true)));
    v = fmaxf(v, __builtin_bit_cast(float, __builtin_amdgcn_update_dpp(0, __builtin_bit_cast(int, v), 0x140, 0xF, 0xF, true)));
    const int iv = __builtin_bit_cast(int, v);
    return fmaxf(fmaxf(__builtin_bit_cast(float, __builtin_amdgcn_readlane(iv, 0)), __builtin_bit_cast(float, __builtin_amdgcn_readlane(iv, 16))),
                 fmaxf(__builtin_bit_cast(float, __builtin_amdgcn_readlane(iv, 32)), __builtin_bit_cast(float, __builtin_amdgcn_readlane(iv, 48))));
}
__device__ __forceinline__ float dpp_xor1(float v) { return __builtin_bit_cast(float, __builtin_amdgcn_update_dpp(0, __builtin_bit_cast(int, v), 0xB1, 0xF, 0xF, true)); }
__device__ __forceinline__ float dpp_xor2(float v) { return __builtin_bit_cast(float, __builtin_amdgcn_update_dpp(0, __builtin_bit_cast(int, v), 0x4E, 0xF, 0xF, true)); }
__device__ __forceinline__ float dpp_hmirror(float v) { return __builtin_bit_cast(float, __builtin_amdgcn_update_dpp(0, __builtin_bit_cast(int, v), 0x141, 0xF, 0xF, true)); }
__device__ __forceinline__ float vsel(bool c, float a, float b) { asm volatile("" : "+v"(a), "+v"(b)); return c ? a : b; }
__device__ __forceinline__ float xor32(float v, int hi) { auto rr = __builtin_amdgcn_permlane32_swap(__float_as_uint(v), __float_as_uint(v), false, false); return __uint_as_float(hi ? rr[0] : rr[1]); }

__device__ __forceinline__ void transpose_item(const float* W, int K, int N, bf16* dst0, int k0, int n0, LAS float* scr, int lane, const float* gk) {
    f32x4 v[8];
#pragma unroll
    for (int i = 0; i < 8; ++i) { const int kk = 8 * i + (lane >> 3); v[i] = __builtin_nontemporal_load((const f32x4*)(W + (size_t)(k0 + kk) * N + n0 + 4 * (lane & 7))); }
#pragma unroll
    for (int i = 0; i < 8; ++i) { const int kk = 8 * i + (lane >> 3); const float g = gk ? gk[k0 + kk] : 1.0f; LAS float* s = scr + kk * 33 + 4 * (lane & 7);
        s[0] = v[i].x * g; s[1] = v[i].y * g; s[2] = v[i].z * g; s[3] = v[i].w * g; }
    LDS_WAIT(); asm volatile("" ::: "memory");
    const int c = lane & 7;
#pragma unroll
    for (int j = 0; j < 4; ++j) { const int n = (lane >> 3) + 8 * j; const LAS float* s = scr + (8 * c) * 33 + n;
        v4u o; o.x = pk2(s[0 * 33], s[1 * 33]); o.y = pk2(s[2 * 33], s[3 * 33]); o.z = pk2(s[4 * 33], s[5 * 33]); o.w = pk2(s[6 * 33], s[7 * 33]);
        *(v4u*)(dst0 + (size_t)n * K + k0 + 8 * c) = o; }
    LDS_WAIT(); asm volatile("" ::: "memory");
}
__device__ __forceinline__ void conv_item(const float* W, int K, int N, bf16* WT, int mode, int item, LAS float* scr, int lane, const float* gk = nullptr) {
    const int nblk = N / 32, kb = item / nblk, nb = item % nblk, k0 = 64 * kb, n0 = 32 * nb;
    const int drow = mode == 0 ? n0 : (256 * (n0 >> 7) + (n0 & 127) + (mode == 2 ? 128 : 0));
    transpose_item(W, K, N, WT + (size_t)drow * K, k0, n0, scr, lane, gk);
}

__device__ __forceinline__ float sumsq8(const f32x4 (&x)[8]) { float ss = 0.f;
#pragma unroll
    for (int j = 0; j < 8; ++j) ss += (x[j].x * x[j].x + x[j].y * x[j].y) + (x[j].z * x[j].z + x[j].w * x[j].w);
    return ss; }
__device__ __forceinline__ void load_bf_row(const bf16* p, int lane, f32x4 (&x)[8]) { const v2u* r = (const v2u*)p + lane; v2u b[8];
#pragma unroll
    for (int j = 0; j < 8; ++j) b[j] = r[64 * j];
#pragma unroll
    for (int j = 0; j < 8; ++j) x[j] = (f32x4){bflo(b[j].x), bfhi(b[j].x), bflo(b[j].y), bfhi(b[j].y)}; }
__device__ __forceinline__ void store_xb_rs(const f32x4 (&x)[8], bf16* XBrow, float* RSrow, int lane) {
    const float r = __builtin_amdgcn_rsqf(wave_sum(sumsq8(x)) * (1.0f / DM) + EPS);
    v2u* o = (v2u*)XBrow + lane;
#pragma unroll
    for (int j = 0; j < 8; ++j) { v2u w; w.x = pk2(x[j].x, x[j].y); w.y = pk2(x[j].z, x[j].w); o[64 * j] = w; }
    if (lane == 0) *RSrow = r;
}
__device__ __forceinline__ void pre_rows(const Frame& F, const float* xin, bf16* XB, float* RS, int nrows) {
    int row = F.gw; f32x4 cur[8], nxt[8];
    if (row < nrows) { const f32x4* xr = (const f32x4*)(xin + (size_t)row * DM) + F.lane;
#pragma unroll
        for (int j = 0; j < 8; ++j) cur[j] = __builtin_nontemporal_load(xr + 64 * j); }
    while (row < nrows) {
        const int nrow = row + F.NGW;
        { const f32x4* xr = (const f32x4*)(xin + (size_t)(nrow < nrows ? nrow : row) * DM) + F.lane;
#pragma unroll
            for (int j = 0; j < 8; ++j) nxt[j] = __builtin_nontemporal_load(xr + 64 * j); }
        store_xb_rs(cur, XB + (size_t)row * DM, RS + row, F.lane);
#pragma unroll
        for (int j = 0; j < 8; ++j) cur[j] = nxt[j];
        row = nrow;
    }
}
template <bool XIN_F32, bool NEXT> struct RowRaw { f32x4 x32[XIN_F32 ? 8 : 1]; v2u xb[XIN_F32 ? 1 : 8]; v2u y[8]; f32x4 n32[NEXT ? 8 : 1]; };
template <bool XIN_F32, bool NEXT>
__device__ __forceinline__ void row_load(RowRaw<XIN_F32, NEXT>& R, const float* xin32, const bf16* XB, const bf16* Y, const float* xnext, int row, int lane) {
    if (XIN_F32) { const f32x4* xr = (const f32x4*)(xin32 + (size_t)row * DM) + lane;
#pragma unroll
        for (int j = 0; j < 8; ++j) R.x32[j] = xr[64 * j]; }
    else { const v2u* xr = (const v2u*)(XB + (size_t)row * DM) + lane;
#pragma unroll
        for (int j = 0; j < 8; ++j) R.xb[j] = xr[64 * j]; }
    { const v2u* yr = (const v2u*)(Y + (size_t)row * DM) + lane;
#pragma unroll
        for (int j = 0; j < 8; ++j) R.y[j] = __builtin_nontemporal_load(yr + 64 * j); }
    if (NEXT) { const f32x4* xr = (const f32x4*)(xnext + (size_t)row * DM) + lane;
#pragma unroll
        for (int j = 0; j < 8; ++j) R.n32[j] = __builtin_nontemporal_load(xr + 64 * j); }
}
template <bool XIN_F32, bool FINAL, bool NEXT>
__device__ __forceinline__ void t_rows(const Frame& F, const float* xin32, const bf16* Y, float coef, const float* gpost, float* out32, bf16* XB, float* RS, const float* xnext, int nrows) {
    f32x4 gp[8];
#pragma unroll
    for (int j = 0; j < 8; ++j) gp[j] = ((const f32x4*)gpost)[64 * j + F.lane];
    int row = F.gw; RowRaw<XIN_F32, NEXT> cur, nxt;
    if (row < nrows) row_load<XIN_F32, NEXT>(cur, xin32, XB, Y, xnext, row, F.lane);
    while (row < nrows) {
        const int nrow = row + F.NGW;
        row_load<XIN_F32, NEXT>(nxt, xin32, XB, Y, xnext, nrow < nrows ? nrow : row, F.lane);
        f32x4 x[8], y[8];
#pragma unroll
        for (int j = 0; j < 8; ++j) { x[j] = XIN_F32 ? cur.x32[j] : (f32x4){bflo(cur.xb[j].x), bfhi(cur.xb[j].x), bflo(cur.xb[j].y), bfhi(cur.xb[j].y)};
            y[j] = (f32x4){bflo(cur.y[j].x), bfhi(cur.y[j].x), bflo(cur.y[j].y), bfhi(cur.y[j].y)}; }
        const float r = coef * __builtin_amdgcn_rsqf(wave_sum(sumsq8(y)) * (1.0f / DM) + EPS);
#pragma unroll
        for (int j = 0; j < 8; ++j) x[j] = x[j] + (y[j] * gp[j]) * r;
        if (FINAL) { f32x4* xo = (f32x4*)(out32 + (size_t)row * DM) + F.lane;
#pragma unroll
            for (int j = 0; j < 8; ++j) __builtin_nontemporal_store(x[j], xo + 64 * j);
            if (NEXT) { f32x4 xn[8];
#pragma unroll
                for (int j = 0; j < 8; ++j) xn[j] = cur.n32[j];
                store_xb_rs(xn, XB + (size_t)row * DM, RS + row, F.lane); } }
        else store_xb_rs(x, XB + (size_t)row * DM, RS + row, F.lane);
        cur = nxt; row = nrow;
    }
}
__device__ __forceinline__ void unpack8(const v4u w, float (&f)[8]) { f[0] = bflo(w.x); f[1] = bfhi(w.x); f[2] = bflo(w.y); f[3] = bfhi(w.y); f[4] = bflo(w.z); f[5] = bfhi(w.z); f[6] = bflo(w.w); f[7] = bfhi(w.w); }
__device__ __forceinline__ float gelu_tanh(float x) { const float z = 1.5957691216057308f * (x + 0.044715f * x * x * x); return x * __builtin_amdgcn_rcpf(1.0f + __builtin_amdgcn_exp2f(-1.4426950408889634f * z)); }
struct MixRaw { v4u o[2], y[2], hf[2], pf[2], hb[2], pb[2]; };
__device__ __forceinline__ void mix_load(MixRaw& R, const bf16* Z, const bf16* HLF, const bf16* PRF, const bf16* HLB, const bf16* PRB, int row, int lane) {
    const bf16* zr = Z + (size_t)row * INW; const size_t ro = (size_t)row * RNNW;
#pragma unroll
    for (int j = 0; j < 2; ++j) { const int c = 512 * j + 8 * lane; R.o[j] = __builtin_nontemporal_load((const v4u*)(zr + ZQ + c)); R.y[j] = __builtin_nontemporal_load((const v4u*)(zr + ZYR + c));
        R.hf[j] = __builtin_nontemporal_load((const v4u*)(HLF + ro + c)); R.pf[j] = __builtin_nontemporal_load((const v4u*)(PRF + ro + c)); R.hb[j] = __builtin_nontemporal_load((const v4u*)(HLB + ro + c)); R.pb[j] = __builtin_nontemporal_load((const v4u*)(PRB + ro + c)); }
}
__device__ __forceinline__ void mix_rows(const Frame& F, const bf16* Z, const bf16* HLF, const bf16* PRF, const bf16* HLB, const bf16* PRB, const float* CIN, const float* ga, const float* gr, bf16* MIX) {
    f32x4 gA[2][2], gR[2][2];
#pragma unroll
    for (int j = 0; j < 2; ++j)
#pragma unroll
        for (int q = 0; q < 2; ++q) { gA[j][q] = *(const f32x4*)(ga + 512 * j + 8 * F.lane + 4 * q); gR[j][q] = *(const f32x4*)(gr + 512 * j + 8 * F.lane + 4 * q); }
    int row = F.gw; MixRaw cur, nxt;
    if (row < MH) mix_load(cur, Z, HLF, PRF, HLB, PRB, row, F.lane);
    while (row < MH) {
        const int nrow = row + F.NGW;
        mix_load(nxt, Z, HLF, PRF, HLB, PRB, nrow < MH ? nrow : row, F.lane);
        const float* cf = CIN + (size_t)(row / LC) * 2 * RNNW; const float* cb = cf + RNNW;
        float o[2][8], rn[2][8]; float sa = 0.f, sr = 0.f;
#pragma unroll
        for (int j = 0; j < 2; ++j) { float y[8], hf[8], pf[8], hb[8], pb[8]; unpack8(cur.o[j], o[j]); unpack8(cur.y[j], y); unpack8(cur.hf[j], hf); unpack8(cur.pf[j], pf); unpack8(cur.hb[j], hb); unpack8(cur.pb[j], pb);
            const int c = 512 * j + 8 * F.lane; const f32x4 f0 = *(const f32x4*)(cf + c), f1 = *(const f32x4*)(cf + c + 4), b0 = *(const f32x4*)(cb + c), b1 = *(const f32x4*)(cb + c + 4);
            const float cfv[8] = {f0.x, f0.y, f0.z, f0.w, f1.x, f1.y, f1.z, f1.w}, cbv[8] = {b0.x, b0.y, b0.z, b0.w, b1.x, b1.y, b1.z, b1.w};
#pragma unroll
            for (int e = 0; e < 8; ++e) { sa += o[j][e] * o[j][e]; const float h = (hf[e] + pf[e] * cfv[e]) + (hb[e] + pb[e] * cbv[e]); rn[j][e] = h * gelu_tanh(y[e]); sr += rn[j][e] * rn[j][e]; } }
        const float ra = __builtin_amdgcn_rsqf(wave_sum(sa) * (1.0f / ATTW) + EPS), rr = __builtin_amdgcn_rsqf(wave_sum(sr) * (1.0f / RNNW) + EPS);
        bf16* mo = MIX + (size_t)row * DM;
#pragma unroll
        for (int j = 0; j < 2; ++j) {
            v4u w; w.x = pk2(o[j][0] * ra * gA[j][0].x, o[j][1] * ra * gA[j][0].y); w.y = pk2(o[j][2] * ra * gA[j][0].z, o[j][3] * ra * gA[j][0].w);
            w.z = pk2(o[j][4] * ra * gA[j][1].x, o[j][5] * ra * gA[j][1].y); w.w = pk2(o[j][6] * ra * gA[j][1].z, o[j][7] * ra * gA[j][1].w);
            *(v4u*)(mo + 512 * j + 8 * F.lane) = w;
            v4u v; v.x = pk2(rn[j][0] * rr * gR[j][0].x, rn[j][1] * rr * gR[j][0].y); v.y = pk2(rn[j][2] * rr * gR[j][0].z, rn[j][3] * rr * gR[j][0].w);
            v.z = pk2(rn[j][4] * rr * gR[j][1].x, rn[j][5] * rr * gR[j][1].y); v.w = pk2(rn[j][6] * rr * gR[j][1].z, rn[j][7] * rr * gR[j][1].w);
            *(v4u*)(mo + ATTW + 512 * j + 8 * F.lane) = v;
        }
        cur = nxt; row = nrow;
    }
}

__device__ __forceinline__ void rope_table(const Frame& F, float* tab) {
    const int gid = F.bid * (NWAVES * 64) + F.tid;
    if (gid < 256 * 32) {
        const int pos = gid >> 5, p = gid & 31;
        double f = 1.0; for (int i = 0; i < p; ++i) f *= 0.7498942093324558;
        const float inv = (float)f; const float ang = (float)pos * inv;
        const double a = (double)ang; const double kq = __builtin_rint(a * 0.6366197723675814); const double r = a - kq * 1.5707963267948966, r2 = r * r;
        const double s = r * (1.0 + r2 * (-1.0 / 6 + r2 * (1.0 / 120 + r2 * (-1.0 / 5040 + r2 * (1.0 / 362880 + r2 * (-1.0 / 39916800 + r2 * (1.0 / 6227020800.0)))))));
        const double c = 1.0 + r2 * (-0.5 + r2 * (1.0 / 24 + r2 * (-1.0 / 720 + r2 * (1.0 / 40320 + r2 * (-1.0 / 3628800 + r2 * (1.0 / 479001600.0))))));
        const int q = ((int)kq) & 3;
        const double cs = q == 0 ? c : (q == 1 ? -s : (q == 2 ? -c : s)), sn = q == 0 ? s : (q == 1 ? c : (q == 2 ? -s : -c));
        tab[2 * gid] = (float)cs; tab[2 * gid + 1] = (float)sn;
    }
}
__device__ __forceinline__ float attn_bound(const float* gqp, const float* gkp, int lane) {
    float mq = fmaxf(fabsf(gqp[lane]), fabsf(gqp[lane + 64])), mk = fmaxf(fabsf(gkp[lane]), fabsf(gkp[lane + 64]));
    mq = wave_max(mq); mk = wave_max(mk);
    return __builtin_bit_cast(float, __builtin_amdgcn_readfirstlane(__builtin_bit_cast(int, 128.0f * mq * mk * att::SCALE)));
}
constexpr float ATT_FIX_MAX = 30.0f;
__device__ __forceinline__ bf16* rope_ptr(bf16* Z, int job, int lane) {
    const int i8 = lane & 7; const bool isq = job < MH;
    const int row = isq ? job : 4 * (job - MH) + (lane >> 4);
    const int col = isq ? (ZQ + (lane >> 3) * 128 + i8 * 16) : (ZK + ((lane >> 3) & 1) * 128 + i8 * 16);
    return Z + (size_t)row * INW + col;
}
__device__ __forceinline__ void rope_rows(const Frame& F, bf16* Z, const float* gqp, const float* gkp, const float* tab, int S) {
    const int i8 = F.lane & 7;
    const float qmul = attn_bound(gqp, gkp, F.lane) <= ATT_FIX_MAX ? att::SCALE * 1.4426950408889634f : 1.0f;
    float gq[16], gk[16];
#pragma unroll
    for (int e = 0; e < 16; ++e) { gq[e] = gqp[16 * i8 + e]; gk[e] = gkp[16 * i8 + e]; }
    const int axis = i8 >> 2, hsel = (i8 >> 1) & 1, p0 = 16 * (i8 & 1);
    constexpr int NJ = MH + MH / 4;
    int job = (qmul != 1.0f ? MH : 0) + F.gw; if (job >= NJ) return;
    v4u w0, w1; { const bf16* p = rope_ptr(Z, job, F.lane); w0 = *(const v4u*)p; w1 = *(const v4u*)(p + 8); }
    while (job < NJ) {
        const int njob = job + F.NGW; v4u n0, n1;
        { const bf16* p = rope_ptr(Z, njob < NJ ? njob : job, F.lane); n0 = *(const v4u*)p; n1 = *(const v4u*)(p + 8); }
        const bool isq = job < MH;
        const int row = isq ? job : 4 * (job - MH) + (F.lane >> 4);
        bf16* p = rope_ptr(Z, job, F.lane);
        float x[16]; { float a[8], b[8]; unpack8(w0, a); unpack8(w1, b);
#pragma unroll
            for (int e = 0; e < 8; ++e) { x[e] = a[e]; x[8 + e] = b[e]; } }
        float ss = 0.f;
#pragma unroll
        for (int e = 0; e < 16; ++e) ss += x[e] * x[e];
        ss += dpp_xor1(ss); ss += dpp_xor2(ss); ss += dpp_hmirror(ss);
        const float rs = __builtin_amdgcn_rsqf(ss * (1.0f / 128) + EPS);
        const int t = row % S; const int pos = axis ? (t & 63) : (t >> 6);
        const f32x4* tp = (const f32x4*)(tab + (size_t)(pos * 32 + p0) * 2);
        float out[16];
#pragma unroll
        for (int e2 = 0; e2 < 8; ++e2) {
            const f32x4 cs = tp[e2];
#pragma unroll
            for (int q = 0; q < 2; ++q) { const int e = 2 * e2 + q; const float xn = x[e] * rs * (isq ? gq[e] * qmul : gk[e]); const float pr = dpp_xor2(xn);
                const float c = q ? cs.z : cs.x, s = q ? cs.w : cs.y; out[e] = hsel ? (xn * c + pr * s) : (xn * c - pr * s); }
        }
        v4u o0, o1; o0.x = pk2(out[0], out[1]); o0.y = pk2(out[2], out[3]); o0.z = pk2(out[4], out[5]); o0.w = pk2(out[6], out[7]);
        o1.x = pk2(out[8], out[9]); o1.y = pk2(out[10], out[11]); o1.z = pk2(out[12], out[13]); o1.w = pk2(out[14], out[15]);
        *(v4u*)p = o0; *(v4u*)(p + 8) = o1;
        w0 = n0; w1 = n1; job = njob;
    }
}

template <int DIR>
__device__ __forceinline__ void rnn_tile_scan(float (&a)[16], float (&u)[16], int hi, float& carry, float& aprod) {
    const int he = DIR ? 1 - hi : hi;
    float Ag[4], Bg[4];
#pragma unroll
    for (int g = 0; g < 4; ++g) { float P = 1.f, H = 0.f;
#pragma unroll
        for (int j = 0; j < 4; ++j) { const int r = DIR ? 15 - (4 * g + j) : 4 * g + j; H = a[r] * H + u[r]; P = P * a[r]; u[r] = H; a[r] = P; }
        Ag[g] = P; Bg[g] = H; }
    float c = carry, ap = aprod;
#pragma unroll
    for (int g = 0; g < 4; ++g) {
        const auto sA = __builtin_amdgcn_permlane32_swap(__float_as_uint(Ag[g]), __float_as_uint(Ag[g]), false, false); const auto sB = __builtin_amdgcn_permlane32_swap(__float_as_uint(Bg[g]), __float_as_uint(Bg[g]), false, false);
        const float A0 = __uint_as_float(sA[DIR]), B0 = __uint_as_float(sB[DIR]), A1 = __uint_as_float(sA[1 - DIR]), B1 = __uint_as_float(sB[1 - DIR]);
        const float c0 = c; c = A0 * c + B0; const float c1 = c; c = A1 * c + B1;
        const float ap0 = ap, ap1 = ap * A0; ap = ap1 * A1;
        const float cown = he ? c1 : c0, apown = he ? ap1 : ap0;
#pragma unroll
        for (int j = 0; j < 4; ++j) { const int r = DIR ? 15 - (4 * g + j) : 4 * g + j; u[r] = u[r] + a[r] * cown; a[r] = a[r] * apown; }
    }
    carry = c; aprod = ap;
}
__device__ __forceinline__ void rnn_store_tile(const float (&x)[16], bf16* base  , int hi, int odd) {
#pragma unroll
    for (int i = 0; i < 8; ++i) { const int r0 = 2 * i, r1 = 2 * i + 1;
        const float recv = dpp_xor1(vsel(odd, x[r0], x[r1]));
        const unsigned w = pk2(vsel(odd, recv, x[r0]), vsel(odd, x[r1], recv));
        const int row = odd ? ((r1 & 3) + 8 * (r1 >> 2) + 4 * hi) : ((r0 & 3) + 8 * (r0 >> 2) + 4 * hi);
        *(unsigned*)(base + (size_t)row * RNNW) = w; }
}
__device__ __forceinline__ void rnn_pass(const Frame& F, ArgP A, int S) {
    LAS unsigned char* img = F.lds + RING_OFF;
    const int dir = F.wave >> 2, cq = F.wave & 3, n = F.lane & 31, hi = F.lane >> 5;
    const bf16* Z = wsp<bf16>(A, WS_Z);
    int cur_blk = -1;
    bf16x8 Wa[8], Wx[8]; float ba = 0.f, bx = 0.f, cneg = 0.f;
    for (int unit = F.bid; unit < NCHUNK * 8; unit += F.G) {
        const int blk = unit & 7, chunk = unit >> 3, zr0 = chunk * LC;
        const int ch = blk * 128 + cq * 32 + n;
        if (blk != cur_blk) {
            cur_blk = blk;
            const float* wa = inp(A, dir ? 18 : 13) + ((size_t)blk * 128 + 8 * hi) * 128 + cq * 32 + n; const float* wx = inp(A, dir ? 20 : 15) + ((size_t)blk * 128 + 8 * hi) * 128 + cq * 32 + n;
#pragma unroll
            for (int ks = 0; ks < 8; ++ks) { float va[8], vx[8];
#pragma unroll
                for (int j = 0; j < 8; ++j) { va[j] = wa[(16 * ks + j) * 128]; vx[j] = wx[(16 * ks + j) * 128]; }
                v4u pa, px; pa.x = pk2(va[0], va[1]); pa.y = pk2(va[2], va[3]); pa.z = pk2(va[4], va[5]); pa.w = pk2(va[6], va[7]);
                px.x = pk2(vx[0], vx[1]); px.y = pk2(vx[2], vx[3]); px.z = pk2(vx[4], vx[5]); px.w = pk2(vx[6], vx[7]);
                Wa[ks] = __builtin_bit_cast(bf16x8, pa); Wx[ks] = __builtin_bit_cast(bf16x8, px); }
            ba = -1.4426950408889634f * inp(A, dir ? 19 : 14)[ch]; bx = -1.4426950408889634f * inp(A, dir ? 21 : 16)[ch];
            cneg = -8.0f * 1.4426950408889634f * log1pf(expf(-inp(A, dir ? 22 : 17)[ch]));
        }
        __syncthreads();
        {
            const int ch4 = (F.tid & 31) * 4;
            const int sq0 = (zr0 / S) * S, sq1 = sq0 + S;
            const float* wcv = inp(A, 11) + blk * 128 + ch4; const f32x4 bc = *(const f32x4*)(inp(A, 12) + blk * 128 + ch4);
            const f32x4 w0 = *(const f32x4*)(wcv), w1 = *(const f32x4*)(wcv + RNNW), w2 = *(const f32x4*)(wcv + 2 * RNNW), w3 = *(const f32x4*)(wcv + 3 * RNNW);
            for (int hh = 0; hh < 2; ++hh) {
                const int r0 = ((F.tid >> 5) + 16 * hh) * 8;
                v2u xin[11];
#pragma unroll
                for (int i = 0; i < 11; ++i) { const int row = zr0 + r0 - 2 + i; const bool ok = row >= sq0 && row < sq1;
                    xin[i] = ok ? __builtin_nontemporal_load((const v2u*)(Z + (size_t)row * INW + ZXR + blk * 128 + ch4)) : (v2u){0u, 0u}; }
#pragma unroll
                for (int rr = 0; rr < 8; ++rr) {
                    const f32x4 x0 = (f32x4){bflo(xin[rr].x), bfhi(xin[rr].x), bflo(xin[rr].y), bfhi(xin[rr].y)}, x1 = (f32x4){bflo(xin[rr + 1].x), bfhi(xin[rr + 1].x), bflo(xin[rr + 1].y), bfhi(xin[rr + 1].y)};
                    const f32x4 x2 = (f32x4){bflo(xin[rr + 2].x), bfhi(xin[rr + 2].x), bflo(xin[rr + 2].y), bfhi(xin[rr + 2].y)}, x3 = (f32x4){bflo(xin[rr + 3].x), bfhi(xin[rr + 3].x), bflo(xin[rr + 3].y), bfhi(xin[rr + 3].y)};
                    const f32x4 xc = bc + ((w0 * x0 + w1 * x1) + (w2 * x2 + w3 * x3));
                    v2u o; o.x = pk2(xc.x, xc.y); o.y = pk2(xc.z, xc.w);
                    const int row = r0 + rr; *(LAS v2u*)(img + row * 256 + ((ch4 * 2) ^ ((row & 7) << 4))) = o; }
            }
        }
        __syncthreads();
        float carry = 0.f, aprod = 1.f;
        bf16* HLo = wsp<bf16>(A, dir ? WS_HLB : WS_HLF) + (size_t)zr0 * RNNW + (ch & ~1); bf16* PRo = wsp<bf16>(A, dir ? WS_PRB : WS_PRF) + (size_t)zr0 * RNNW + (ch & ~1);
        for (int it = 0; it < 8; ++it) {
            const int rt = dir ? 7 - it : it;
            f32x16 ca = {}, cx = {};
#pragma unroll
            for (int ks = 0; ks < 8; ++ks) { const int row = 32 * rt + n; const bf16x8 Af = *(const LAS bf16x8*)(img + row * 256 + ((32 * ks + 16 * hi) ^ ((row & 7) << 4)));
                ca = __builtin_amdgcn_mfma_f32_32x32x16_bf16(Af, Wa[ks], ca, 0, 0, 0); cx = __builtin_amdgcn_mfma_f32_32x32x16_bf16(Af, Wx[ks], cx, 0, 0, 0); }
            float a[16], u[16];
#pragma unroll
            for (int r = 0; r < 16; ++r) { const int row = 32 * rt + (r & 3) + 8 * (r >> 2) + 4 * hi;
                const float xcv = __uint_as_float((unsigned)(*(const LAS unsigned short*)(img + row * 256 + (((cq * 32 + n) * 2) ^ ((row & 7) << 4)))) << 16);
                const float rg_ = __builtin_amdgcn_rcpf(1.0f + __builtin_amdgcn_exp2f(fmaf(ca[r], -1.4426950408889634f, ba)));
                const float ig = __builtin_amdgcn_rcpf(1.0f + __builtin_amdgcn_exp2f(fmaf(cx[r], -1.4426950408889634f, bx)));
                const float av = __builtin_amdgcn_exp2f(cneg * rg_);
                a[r] = av; u[r] = __builtin_amdgcn_sqrtf(fmaxf(fmaf(-av, av, 1.0f), 0.f)) * (ig * xcv); }
            if (dir == 0) rnn_tile_scan<0>(a, u, hi, carry, aprod); else rnn_tile_scan<1>(a, u, hi, carry, aprod);
            rnn_store_tile(u, HLo + (size_t)(32 * rt) * RNNW, hi, n & 1);
            rnn_store_tile(a, PRo + (size_t)(32 * rt) * RNNW, hi, n & 1);
        }
        if (hi == 0) wsp<f32x2>(A, WS_SUM)[((size_t)chunk * 2 + dir) * RNNW + ch] = (f32x2){aprod, carry};
    }
}
__device__ __forceinline__ void rnn_carry(const Frame& F, const f32x2* SUM, float* CIN, int nseq, int cps) {
    const int gid = F.bid * (NWAVES * 64) + F.tid;
    if (gid >= nseq * 2 * RNNW) return;
    const int s = gid / (2 * RNNW), rem = gid % (2 * RNNW), dir = rem / RNNW, ch = rem % RNNW;
    float st = 0.f;
#pragma unroll 8
    for (int i = 0; i < cps; ++i) { const int c = s * cps + (dir ? cps - 1 - i : i); const size_t o = ((size_t)c * 2 + dir) * RNNW + ch;
        CIN[o] = st; const f32x2 ab = SUM[o]; st = ab.x * st + ab.y; }
}

constexpr int PH_PER_HALF = 12, N_PHASES = 1 + 2 * PH_PER_HALF;
#define IN(k) (LO <= (k) && (k) < HI)
#define SEAM(k) do { if constexpr (LO <= (k) && (k) + 1 < HI) xcd_barrier(bar); } while (0)
#ifndef GEMM_ALIGN
#define GEMM_ALIGN true
#endif
#ifndef GEMM_SP2
#define GEMM_SP2 true
#endif
#define GEMM_SITE(EPI, Aoff, Boff, N_, K_, Ooff, ldo, RSP) do { Frame F = mkframe(lds, bar.wv); ArgP A = argp(); \
        pg8::Gemm g{wsp<bf16>(A, Aoff), wsp<bf16>(A, Boff), MH, N_, K_}; pg8::StaticOrder So; So.init(MH, N_, F.G, F.bid); \
        EPI E{wsp<bf16>(A, Ooff), ldo, RSP}; pg8::gemm_phase<EPI, pg8::StaticOrder, GEMM_ALIGN, GEMM_SP2>(F.lds + RING_OFF, g, So, E, F.tid); } while (0)

template <int H, int LO, int HI>
__device__ __forceinline__ void trunk(unsigned char* lds, const XcdBarrier& bar) {
    constexpr int pb = 1 + H * PH_PER_HALF;
    constexpr int S = H ? 16384 : 4096;
    constexpr size_t xoff = (size_t)H * MH * DM;
    if constexpr (IN(pb + 0)) GEMM_SITE(pg8::EpiSwiglu, WS_XN, WS_WGU1, NGU, DM, WS_H, DFF, wsp<float>(A, WS_RS));
    SEAM(pb + 0);
    if constexpr (IN(pb + 1)) GEMM_SITE(pg8::EpiBf16, WS_H, WS_WD1, DM, DFF, WS_Y, DM, nullptr);
    SEAM(pb + 1);
    if constexpr (IN(pb + 2)) { Frame F = mkframe(lds, bar.wv); ArgP A = argp();
        t_rows<false, false, false>(F, nullptr, wsp<bf16>(A, WS_Y), 0.5f, inp(A, 6), nullptr, wsp<bf16>(A, WS_XN), wsp<float>(A, WS_RS), nullptr, MH); }
    SEAM(pb + 2);
    if constexpr (IN(pb + 3)) GEMM_SITE(pg8::EpiBf16, WS_XN, WS_WIN, INW, DM, WS_Z, INW, wsp<float>(A, WS_RS));
    SEAM(pb + 3);
    if constexpr (IN(pb + 4)) {
        { Frame F = mkframe(lds, bar.wv); ArgP A = argp(); rope_rows(F, wsp<bf16>(A, WS_Z), inp(A, 9), inp(A, 10), wsp<float>(A, WS_ROPE), S); }
        { Frame F = mkframe(lds, bar.wv); ArgP A = argp(); rnn_pass(F, A, S); }
        __syncthreads();
    }
    SEAM(pb + 4);
    if constexpr (IN(pb + 5)) {
        { Frame F = mkframe(lds, bar.wv); ArgP A = argp(); rnn_carry(F, wsp<f32x2>(A, WS_SUM), wsp<float>(A, WS_CIN), MH / S, S / LC); }
        Frame F = mkframe(lds, bar.wv); ArgP A = argp();
        const bf16* Zb = wsp<bf16>(A, WS_Z);
        const float mfix = attn_bound(inp(A, 9), inp(A, 10), F.lane); const bool fixm = mfix <= ATT_FIX_MAX;
#define ATT_LOOP(FIX) do { Frame F2 = mkframe<(FIX) ? 1 : 2>(lds, bar.wv); ArgP A2 = argp(); const bf16* Zb2 = wsp<bf16>(A2, WS_Z); const int x = F2.bid & 7, rk = F2.bid >> 3; constexpr int nqb = S / 256, UG = 4 * nqb; \
        for (int idx = F2.bid; idx < 1024; idx += F2.G) { int id = idx; if (F2.G == 256) { const int t = (idx - F2.bid) / 256; id = x * 128 + t * 32 + rk; }     \
            const int grp = id / UG, uu = id % UG, b = grp >> 1, kvh = grp & 1, head = kvh * 4 + uu / nqb, qb = uu % nqb; \
            const bf16* zb = Zb2 + (size_t)b * S * INW; bf16* qp = (bf16*)zb + (size_t)qb * 256 * INW + ZQ + head * 128; \
            if constexpr ((FIX) && ATT_MFMA16) att::attn_unit16<S / 64>(qp, zb + ZK + kvh * 128, zb + ZV + kvh * 128, qp, (char*)lds + RING_OFF, F2.lds + RING_OFF, F2.tid, inp(A2, 9), wsp<float>(A2, WS_ROPE), qb * 256, att::SCALE * 1.4426950408889634f); \
            else att::attn_unit<FIX, S / 64>(qp, zb + ZK + kvh * 128, zb + ZV + kvh * 128, qp, S, (char*)lds + RING_OFF, F2.lds + RING_OFF, F2.tid, mfix, inp(A2, 9), wsp<float>(A2, WS_ROPE), qb * 256, (FIX) ? att::SCALE * 1.4426950408889634f : 1.0f); } } while (0)
        if (fixm) ATT_LOOP(true); else ATT_LOOP(false);
#undef ATT_LOOP
    }
    SEAM(pb + 5);
    if constexpr (IN(pb + 6)) { Frame F = mkframe(lds, bar.wv); ArgP A = argp();
        mix_rows(F, wsp<bf16>(A, WS_Z), wsp<bf16>(A, WS_HLF), wsp<bf16>(A, WS_PRF), wsp<bf16>(A, WS_HLB), wsp<bf16>(A, WS_PRB), wsp<float>(A, WS_CIN), inp(A, 23), inp(A, 24), wsp<bf16>(A, WS_MIX)); }
    SEAM(pb + 6);
    if constexpr (IN(pb + 7)) GEMM_SITE(pg8::EpiBf16, WS_MIX, WS_WOUT, DM, DM, WS_Y, DM, nullptr);
    SEAM(pb + 7);
    if constexpr (IN(pb + 8)) { Frame F = mkframe(lds, bar.wv); ArgP A = argp();
        t_rows<false, false, false>(F, nullptr, wsp<bf16>(A, WS_Y), 1.0f, inp(A, 26), nullptr, wsp<bf16>(A, WS_XN), wsp<float>(A, WS_RS), nullptr, MH); }
    SEAM(pb + 8);
    if constexpr (IN(pb + 9)) GEMM_SITE(pg8::EpiSwiglu, WS_XN, WS_WGU2, NGU, DM, WS_H, DFF, wsp<float>(A, WS_RS));
    SEAM(pb + 9);
    if constexpr (IN(pb + 10)) GEMM_SITE(pg8::EpiBf16, WS_H, WS_WD2, DM, DFF, WS_Y, DM, nullptr);
    SEAM(pb + 10);
    if constexpr (IN(pb + 11)) { Frame F = mkframe(lds, bar.wv); ArgP A = argp();
        t_rows<false, true, H == 0>(F, nullptr, wsp<bf16>(A, WS_Y), 0.5f, inp(A, 31), outp(A) + xoff, wsp<bf16>(A, WS_XN), wsp<float>(A, WS_RS), H == 0 ? inp(A, 1) : nullptr, MH); }
    if constexpr (H == 0) SEAM(pb + 11);
}

template <int LO, int HI>
__global__ void __launch_bounds__(NWAVES * 64, 2) hymba_fwd(Args args_unused) {
    extern __shared__ __attribute__((aligned(16))) unsigned char lds[];
    {   LAS unsigned char* l = (LAS unsigned char*)lds;
        for (int u = threadIdx.x; u < (LDS_BYTES - LDSCTL_OFF) / 4; u += NWAVES * 64) ((LAS unsigned*)(l + LDSCTL_OFF))[u] = 0u; }
    __syncthreads();
    int wv0 = __builtin_amdgcn_readfirstlane((int)threadIdx.x >> 6); asm volatile("" : "+s"(wv0));
    XcdBarrier bar; bar.bar = nullptr; bar.x = 0; bar.st = nullptr; bar.wv = wv0;
    if constexpr (HI - LO > 1) { ArgP A = argp(); bar = xcd_barrier_post(wsp<unsigned>(A, WS_CTL) + CW_BAR, (volatile LAS unsigned*)((LAS unsigned char*)lds + MISC_OFF) + 8, wv0); }

    if constexpr (IN(0)) {
        Frame F = mkframe(lds, bar.wv); ArgP A = argp();
        LAS float* scr = (LAS float*)(F.lds + RING_OFF + F.wave * 16384);
        constexpr int I_GU = (DM / 64) * (DFF / 32), I_D = (DFF / 64) * (DM / 32), I_IN = (DM / 64) * (INW / 32), I_O = (DM / 64) * (DM / 32);
        constexpr int NITEMS = 4 * I_GU + 2 * I_D + I_IN + I_O;
        for (int it = F.gw; it < NITEMS; it += F.NGW) {
            int r = it;
            if (r < I_GU) { conv_item(inp(A, 3), DM, DFF, wsp<bf16>(A, WS_WGU1), 1, r, scr, F.lane, inp(A, 2)); continue; } r -= I_GU;
            if (r < I_GU) { conv_item(inp(A, 4), DM, DFF, wsp<bf16>(A, WS_WGU1), 2, r, scr, F.lane, inp(A, 2)); continue; } r -= I_GU;
            if (r < I_D)  { conv_item(inp(A, 5), DFF, DM, wsp<bf16>(A, WS_WD1), 0, r, scr, F.lane); continue; } r -= I_D;
            if (r < I_IN) { conv_item(inp(A, 8), DM, INW, wsp<bf16>(A, WS_WIN), 0, r, scr, F.lane, inp(A, 7)); continue; } r -= I_IN;
            if (r < I_O)  { conv_item(inp(A, 25), DM, DM, wsp<bf16>(A, WS_WOUT), 0, r, scr, F.lane); continue; } r -= I_O;
            if (r < I_GU) { conv_item(inp(A, 28), DM, DFF, wsp<bf16>(A, WS_WGU2), 1, r, scr, F.lane, inp(A, 27)); continue; } r -= I_GU;
            if (r < I_GU) { conv_item(inp(A, 29), DM, DFF, wsp<bf16>(A, WS_WGU2), 2, r, scr, F.lane, inp(A, 27)); continue; } r -= I_GU;
            conv_item(inp(A, 30), DFF, DM, wsp<bf16>(A, WS_WD2), 0, r, scr, F.lane);
        }
        rope_table(F, wsp<float>(A, WS_ROPE));
        pre_rows(F, inp(A, 0), wsp<bf16>(A, WS_XN), wsp<float>(A, WS_RS), MH);
    }
    SEAM(0);
    trunk<0, LO, HI>(lds, bar);
    trunk<1, LO, HI>(lds, bar);
}
#undef IN
#undef SEAM

template <int LO, int HI> static bool launch_range(int grid, hipStream_t stream, const Args& a) {
    static int ok = 0;
    if (ok == 0) { ok = (hipFuncSetAttribute((const void*)hymba_fwd<LO, HI>, hipFuncAttributeMaxDynamicSharedMemorySize, LDS_BYTES) == hipSuccess) ? 1 : -1;
        if (ok < 0) fprintf(stderr, "kernel_launch: hipFuncSetAttribute failed for phases [%d, %d)\n", LO, HI); }
    if (ok < 0) return false;
    hipLaunchKernelGGL((hymba_fwd<LO, HI>), dim3(grid), dim3(NWAVES * 64), LDS_BYTES, stream, a);
    return true;
}
#if MK_PER_PHASE
template <int P> static void launch_from(int grid, hipStream_t stream, const Args& a) {
    if constexpr (P < N_PHASES) { launch_range<P, P + 1>(grid, stream, a); launch_from<P + 1>(grid, stream, a); }
}
#endif
extern "C" void kernel_launch(void* const* d_in, const int* in_sizes, int n_in, void* d_out, int out_size, void* d_ws, size_t ws_size, hipStream_t stream) {
    static int grid = 0;
    if (grid == 0) {
        if (n_in != 32 || in_sizes[0] != MH * DM || in_sizes[1] != MH * DM || out_size != 2 * MH * DM || ws_size < WS_END) {
            fprintf(stderr, "kernel_launch: unexpected shapes (n_in %d, out %d, ws %zu); nothing launched\n", n_in, out_size, ws_size); grid = -1; return; }
        int dev = 0, cus = 0;
        if (hipGetDevice(&dev) != hipSuccess || hipDeviceGetAttribute(&cus, hipDeviceAttributeMultiprocessorCount, dev) != hipSuccess) { grid = -1; return; }
        int per_cu = 0;
#if MK_PER_PHASE
        per_cu = 1;
#else
        if (hipFuncSetAttribute((const void*)hymba_fwd<0, N_PHASES>, hipFuncAttributeMaxDynamicSharedMemorySize, LDS_BYTES) != hipSuccess ||
            hipOccupancyMaxActiveBlocksPerMultiprocessor(&per_cu, (const void*)hymba_fwd<0, N_PHASES>, NWAVES * 64, LDS_BYTES) != hipSuccess || per_cu < 1) {
            fprintf(stderr, "kernel_launch: the occupancy query reports %d workgroups per CU for this kernel; launching one per CU anyway\n", per_cu); per_cu = 1; }
        (void)hipGetLastError();
#endif
        grid = cus * (per_cu < 1 ? per_cu : 1);
    }
    if (grid < 0) return;
    if (hipMemsetAsync((char*)d_ws + WS_CTL, 0, CTL_ZERO_BYTES, stream) != hipSuccess) return;
    Args a{};
    for (int i = 0; i < 32; ++i) a.in[i] = (unsigned long long)(uintptr_t)d_in[i];
    a.out = (unsigned long long)(uintptr_t)d_out; a.ws = (unsigned long long)(uintptr_t)d_ws;
    a.ph_lo = 0; a.ph_hi = N_PHASES;
#if MK_PER_PHASE
    launch_from<0>(grid, stream, a);
#else
    launch_range<0, N_PHASES>(grid, stream, a);
#endif
    const hipError_t le = hipPeekAtLastError();
    if (le != hipSuccess) fprintf(stderr, "kernel_launch: launch failed: %s\n", hipGetErrorName(le));
}
```

```cpp
#include <hip/hip_runtime.h>
#include <cstdio>
#include <cstdint>

#ifndef MK_PER_PHASE
#define MK_PER_PHASE 0
#endif

namespace pg8 {
#define PG8_LAS __attribute__((address_space(3)))
typedef unsigned short bf16_t;
typedef short bf16x8 __attribute__((ext_vector_type(8)));
typedef float f32x4 __attribute__((ext_vector_type(4)));
typedef unsigned u32x4 __attribute__((ext_vector_type(4)));
constexpr int BM = 256, BK = 64, HALF = 128, HTB = HALF * BK * 2  , STAGE_BYTES = 8 * HTB, NXCD = 8, WGM = 4;

__host__ __device__ __forceinline__ int lds_byte(int r, int c) { const int st = (r >> 4) * 2 + (c >> 5), rr = r & 15, cc = c & 31, ob = rr * 64 + cc * 2; return st * 1024 + (ob ^ (((ob >> 9) & 1) << 5)); }
__host__ __device__ __forceinline__ void stage_rc(int b, int& R, int& C) { const int st = b / 1024, sb = b % 1024, swz = sb ^ (((sb >> 9) & 1) << 5); R = (st >> 1) * 16 + swz / 64; C = (st & 1) * 32 + (swz % 64) / 2; }
__host__ __device__ __forceinline__ int perm32(int rho) { const int n = rho >> 4, i = rho & 15; return 8 * (i >> 2) + 4 * n + (i & 3); }

struct Unit { int pm, pn; };
struct Gemm { const bf16_t* A; const bf16_t* Bt; int M, N, K; };

struct StaticOrder {
    int nM, nN, nwg, G, c;
    __host__ __device__ void init(int M, int N, int G_, int c_) { nM = M / BM; nN = N / BM; nwg = nM * nN; G = G_; c = c_; }
    __host__ __device__ bool next(int i, Unit& u) const {
        const long L = (long)i * G + c; if (L >= nwg) return false;
        int wgid = (int)L; { const int q = nwg / NXCD, r = nwg % NXCD, xcd = wgid % NXCD, off = wgid / NXCD; wgid = (xcd < r ? xcd * (q + 1) : r * (q + 1) + (xcd - r) * q) + off; }
        const int nig = WGM * nN, gid = wgid / nig, fm = gid * WGM, gsz = (nM - fm) < WGM ? (nM - fm) : WGM;
        u.pm = fm + ((wgid % nig) % gsz); u.pn = (wgid % nig) / gsz; return true;
    }
    __device__ __forceinline__ void a_ready(const Unit&) const {}
    __device__ __forceinline__ void done(const Unit&) const {}
};

__device__ __forceinline__ unsigned cvt_pk_bf16(float lo, float hi) { unsigned r; asm volatile("v_cvt_pk_bf16_f32 %0, %1, %2" : "=v"(r) : "v"(lo), "v"(hi)); return r; }

struct EpiBf16 {
    static constexpr bool PERM = true, AFTER_DRAIN = false;
    bf16_t* O; int ldc; const float* rs;
    __device__ __forceinline__ void operator()(const f32x4 (&acc)[2][2][4][2], const Unit& u, int wr, int wc, int fr, int fq) const {
        const int row0 = u.pm * BM + wr * 64 + fr; const int col0 = u.pn * BM + wc * 32 + 8 * fq;
#pragma unroll
        for (int ai = 0; ai < 2; ++ai)
#pragma unroll
            for (int m = 0; m < 4; ++m) { const int row = row0 + ai * HALF + m * 16; bf16_t* rowp = O + (size_t)row * ldc + col0; const float s = rs ? rs[row] : 1.0f;
#pragma unroll
                for (int bj = 0; bj < 2; ++bj) { const f32x4 v0 = acc[ai][bj][m][0] * s, v1 = acc[ai][bj][m][1] * s;
                    u32x4 w; w.x = cvt_pk_bf16(v0[0], v0[1]); w.y = cvt_pk_bf16(v0[2], v0[3]); w.z = cvt_pk_bf16(v1[0], v1[1]); w.w = cvt_pk_bf16(v1[2], v1[3]);
                    *(u32x4*)(rowp + bj * HALF) = w; } }
    }
};
__device__ __forceinline__ float silu_mul(float g, float u) { const float e = __builtin_amdgcn_exp2f(g * -1.4426950408889634f); return g * u * __builtin_amdgcn_rcpf(1.0f + e); }
struct EpiSwiglu {
    static constexpr bool PERM = true, AFTER_DRAIN = false;
    bf16_t* O; int ldc; const float* rs;
    __device__ __forceinline__ void operator()(const f32x4 (&acc)[2][2][4][2], const Unit& u, int wr, int wc, int fr, int fq) const {
        const int row0 = u.pm * BM + wr * 64 + fr; const int col0 = u.pn * HALF + wc * 32 + 8 * fq;
#pragma unroll
        for (int ai = 0; ai < 2; ++ai)
#pragma unroll
            for (int m = 0; m < 4; ++m) { const int row = row0 + ai * HALF + m * 16; bf16_t* rowp = O + (size_t)row * ldc + col0; const float s = rs[row];
                const f32x4 g0 = acc[ai][0][m][0] * s, g1 = acc[ai][0][m][1] * s, u0 = acc[ai][1][m][0] * s, u1 = acc[ai][1][m][1] * s;
                u32x4 w; w.x = cvt_pk_bf16(silu_mul(g0[0], u0[0]), silu_mul(g0[1], u0[1])); w.y = cvt_pk_bf16(silu_mul(g0[2], u0[2]), silu_mul(g0[3], u0[3]));
                w.z = cvt_pk_bf16(silu_mul(g1[0], u1[0]), silu_mul(g1[1], u1[1])); w.w = cvt_pk_bf16(silu_mul(g1[2], u1[2]), silu_mul(g1[3], u1[3]));
                *(u32x4*)rowp = w; }
    }
};

template <class Epi, class Sched, bool ALIGN_EPI = false, bool SP2 = false>
__device__ __forceinline__ void gemm_phase(PG8_LAS unsigned char* lds, const Gemm g, const Sched& S, const Epi& E, const int tid) {
    const int wid = __builtin_amdgcn_readfirstlane(tid >> 6), lane = tid & 63, wr = wid >> 2, wc = wid & 3, fr = lane & 15, fq = lane >> 4;
    const int K = g.K, nt = K / BK;
    unsigned voffA[2], voffB[2];
#pragma unroll
    for (int i = 0; i < 2; ++i) { int R, C; stage_rc(tid * 16 + i * 8192, R, C); const int Rb = Epi::PERM ? ((R & ~31) + perm32(R & 31)) : R;
        voffA[i] = (unsigned)(R * K + C) * 2u; voffB[i] = (unsigned)(Rb * K + C) * 2u; }
    const size_t kstep = (size_t)(BK * 2);
    const size_t hstep = (size_t)HALF * K * 2;
    const size_t tstep = 2 * hstep;
    const unsigned ldsw = (unsigned)wid * 1024u;
    const int aoff = lds_byte(wr * 64 + fr, fq * 8), boff = lds_byte(wc * 32 + fr, fq * 8);
#define PG8_SA(b, h) (((b) * 2 + (h)) * HTB)
#define PG8_SB(b, h) ((4 + (b) * 2 + (h)) * HTB)
#define PG8_STAGE(bufoff, gbase, voff) do { _Pragma("unroll") for (int _i = 0; _i < 2; ++_i) \
        __builtin_amdgcn_global_load_lds((const unsigned*)((const char*)(gbase) + (voff)[_i]), (PG8_LAS unsigned*)(lds + (bufoff) + ldsw + _i * 8192), 16, 0, 0); } while (0)
#define PG8_LDA(dst, b, h) do { _Pragma("unroll") for (int m = 0; m < 4; ++m) _Pragma("unroll") for (int k = 0; k < 2; ++k) dst[m][k] = *(const PG8_LAS bf16x8*)(lds + PG8_SA(b, h) + aoff + m * 2048 + k * 1024); } while (0)
#define PG8_LDB(dst, b, h) do { _Pragma("unroll") for (int n = 0; n < 2; ++n) _Pragma("unroll") for (int k = 0; k < 2; ++k) dst[n][k] = *(const PG8_LAS bf16x8*)(lds + PG8_SB(b, h) + boff + n * 2048 + k * 1024); } while (0)
#define PG8_MMA(ai, bj, At, Bt) do { __builtin_amdgcn_s_setprio(1); _Pragma("unroll") for (int m = 0; m < 4; ++m) _Pragma("unroll") for (int n = 0; n < 2; ++n) _Pragma("unroll") for (int k = 0; k < 2; ++k) \
        acc[ai][bj][m][n] = __builtin_amdgcn_mfma_f32_16x16x32_bf16(Bt[n][k], At[m][k], acc[ai][bj][m][n], 0, 0, 0); __builtin_amdgcn_s_setprio(0); } while (0)
#define PG8_WAIT_V(n) asm volatile("s_waitcnt vmcnt(" #n ")" ::: "memory")
#define PG8_WAIT_L(n) asm volatile("s_waitcnt lgkmcnt(" #n ")" ::: "memory")
#define PG8_BAR __builtin_amdgcn_s_barrier()
#define PG8_SCHED __builtin_amdgcn_sched_barrier(0)
    Unit cur, nxt; int ui = 0;
    if (!S.next(0, cur)) return;
    f32x4 acc[2][2][4][2];
#pragma unroll
    for (int a = 0; a < 2; ++a)
#pragma unroll
        for (int b = 0; b < 2; ++b)
#pragma unroll
            for (int m = 0; m < 4; ++m)
#pragma unroll
                for (int n = 0; n < 2; ++n) acc[a][b][m][n] = (f32x4){0.f, 0.f, 0.f, 0.f};
    bf16x8 At[4][2], B0[2][2], B1[2][2];
    const char* cA = (const char*)g.A + (size_t)cur.pm * tstep; const char* cB = (const char*)g.Bt + (size_t)cur.pn * tstep;
    S.a_ready(cur);
    if constexpr (SP2) {
        PG8_STAGE(PG8_SB(0, 0), cB, voffB); PG8_STAGE(PG8_SB(0, 1), cB + hstep, voffB); PG8_STAGE(PG8_SA(0, 0), cA, voffA); PG8_STAGE(PG8_SA(0, 1), cA + hstep, voffA);
        if (wr == 1) PG8_BAR;
        PG8_WAIT_V(2); PG8_BAR;
        PG8_STAGE(PG8_SB(1, 0), cB + kstep, voffB); PG8_STAGE(PG8_SA(1, 0), cA + kstep, voffA); PG8_STAGE(PG8_SB(1, 1), cB + hstep + kstep, voffB);
        PG8_WAIT_V(6); PG8_BAR;
    } else {
        PG8_STAGE(PG8_SB(0, 0), cB, voffB); PG8_STAGE(PG8_SA(0, 0), cA, voffA); PG8_STAGE(PG8_SB(0, 1), cB + hstep, voffB); PG8_STAGE(PG8_SA(0, 1), cA + hstep, voffA);
        if (wr == 1) PG8_BAR;
        PG8_WAIT_V(4); PG8_BAR;
        PG8_STAGE(PG8_SB(1, 0), cB + kstep, voffB); PG8_STAGE(PG8_SA(1, 0), cA + kstep, voffA); PG8_STAGE(PG8_SB(1, 1), cB + hstep + kstep, voffB);
        PG8_WAIT_V(6); PG8_BAR;
    }
    for (;;) {
        const bool has_next = S.next(ui + 1, nxt);
        const char* nA = has_next ? (const char*)g.A + (size_t)nxt.pm * tstep : cA; const char* nB = has_next ? (const char*)g.Bt + (size_t)nxt.pn * tstep : cB;
        for (int t = 0; t < nt; t += 2) {
            const bool last = (t == nt - 2);
            const char* a1 = cA + (size_t)(t + 1) * kstep;
            const char* a2 = last ? nA : cA + (size_t)(t + 2) * kstep; const char* b2 = last ? nB : cB + (size_t)(t + 2) * kstep;
            const char* a3 = a2 + kstep; const char* b3 = b2 + kstep;
            if (last && has_next) S.a_ready(nxt);
            if constexpr (SP2) {
            PG8_LDB(B0, 0, 0); PG8_LDB(B1, 0, 1); PG8_SCHED; PG8_LDA(At, 0, 0); PG8_STAGE(PG8_SA(1, 1), a1 + hstep, voffA);
            PG8_WAIT_V(8); PG8_WAIT_L(0); PG8_BAR; PG8_MMA(0, 0, At, B0); PG8_MMA(0, 1, At, B1); PG8_BAR; PG8_SCHED;
            PG8_LDA(At, 0, 1); PG8_STAGE(PG8_SB(0, 0), b2, voffB); PG8_STAGE(PG8_SB(0, 1), b2 + hstep, voffB); PG8_STAGE(PG8_SA(0, 0), a2, voffA);
            PG8_WAIT_V(8); PG8_WAIT_L(0); PG8_BAR; PG8_MMA(1, 0, At, B0); PG8_MMA(1, 1, At, B1); PG8_BAR; PG8_SCHED;
            PG8_LDB(B0, 1, 0); PG8_LDB(B1, 1, 1); PG8_SCHED; PG8_LDA(At, 1, 0); PG8_STAGE(PG8_SA(0, 1), a2 + hstep, voffA);
            PG8_WAIT_V(8); PG8_WAIT_L(0); PG8_BAR; PG8_MMA(0, 0, At, B0); PG8_MMA(0, 1, At, B1); PG8_BAR; PG8_SCHED;
            PG8_LDA(At, 1, 1); PG8_STAGE(PG8_SB(1, 0), b3, voffB); PG8_STAGE(PG8_SB(1, 1), b3 + hstep, voffB); PG8_STAGE(PG8_SA(1, 0), a3, voffA);
            PG8_WAIT_V(8); PG8_WAIT_L(0); PG8_BAR; PG8_MMA(1, 0, At, B0); PG8_MMA(1, 1, At, B1); PG8_BAR; PG8_SCHED;
            } else {
            PG8_LDB(B0, 0, 0); PG8_SCHED; PG8_LDA(At, 0, 0); PG8_STAGE(PG8_SA(1, 1), a1 + hstep, voffA);
            PG8_WAIT_L(8); PG8_BAR; PG8_WAIT_L(0); PG8_MMA(0, 0, At, B0); PG8_BAR; PG8_SCHED;
            PG8_LDB(B1, 0, 1); PG8_STAGE(PG8_SB(0, 0), b2, voffB);
            PG8_BAR; PG8_WAIT_L(0); PG8_MMA(0, 1, At, B1); PG8_BAR;
            PG8_LDA(At, 0, 1); PG8_STAGE(PG8_SA(0, 0), a2, voffA);
            PG8_BAR; PG8_WAIT_L(0); PG8_MMA(1, 0, At, B0); PG8_BAR; PG8_SCHED;
            PG8_STAGE(PG8_SB(0, 1), b2 + hstep, voffB);
            PG8_WAIT_V(6); PG8_BAR; PG8_MMA(1, 1, At, B1); PG8_BAR;
            PG8_LDB(B0, 1, 0); PG8_SCHED; PG8_LDA(At, 1, 0); PG8_STAGE(PG8_SA(0, 1), a2 + hstep, voffA);
            PG8_WAIT_L(8); PG8_BAR; PG8_WAIT_L(0); PG8_MMA(0, 0, At, B0); PG8_BAR; PG8_SCHED;
            PG8_LDB(B1, 1, 1); PG8_STAGE(PG8_SB(1, 0), b3, voffB);
            PG8_BAR; PG8_WAIT_L(0); PG8_MMA(0, 1, At, B1); PG8_BAR;
            PG8_LDA(At, 1, 1); PG8_STAGE(PG8_SA(1, 0), a3, voffA);
            PG8_BAR; PG8_WAIT_L(0); PG8_MMA(1, 0, At, B0); PG8_BAR; PG8_SCHED;
            PG8_STAGE(PG8_SB(1, 1), b3 + hstep, voffB);
            PG8_WAIT_V(6); PG8_BAR; PG8_MMA(1, 1, At, B1); PG8_BAR;
            }
        }
        if constexpr (ALIGN_EPI) { if (wr == 0) PG8_BAR; }
        E(acc, cur, wr, wc, fr, fq); S.done(cur);
        if (!has_next) break;
#pragma unroll
        for (int a = 0; a < 2; ++a)
#pragma unroll
            for (int b = 0; b < 2; ++b)
#pragma unroll
                for (int m = 0; m < 4; ++m)
#pragma unroll
                    for (int n = 0; n < 2; ++n) acc[a][b][m][n] = (f32x4){0.f, 0.f, 0.f, 0.f};
        cur = nxt; cA = nA; cB = nB; ++ui;
        if constexpr (ALIGN_EPI) { if (wr == 1) PG8_BAR; }
    }
    PG8_WAIT_V(0);
    if constexpr (!ALIGN_EPI) { if (wr == 0) PG8_BAR; }
    PG8_BAR;
#undef PG8_SA
#undef PG8_SB
#undef PG8_STAGE
#undef PG8_LDA
#undef PG8_LDB
#undef PG8_MMA
#undef PG8_WAIT_V
#undef PG8_WAIT_L
#undef PG8_BAR
#undef PG8_SCHED
}
}

namespace att {
typedef unsigned short bf16;
constexpr int D = 128, NW = 8, QBLK = 32, KVBLK = 64;
constexpr float SCALE = 0.088388347648318440f;
constexpr float THR = 8.f;
#ifndef ATT_MFMA16
#define ATT_MFMA16 1
#endif
#ifndef ATT_RING
#define ATT_RING 1
#endif
#ifndef ATT_SDEPTH_FIX
#define ATT_SDEPTH_FIX 2
#endif
constexpr int LDQ = 3584, LDK = 3584, LDO = 3584;
constexpr size_t SHM_V = KVBLK * D * 2, SHM_K = KVBLK * D * 2, SHM_ATTN = 2 * SHM_V + 2 * SHM_K + NW * 64 * 4;
using bf16x8 = __attribute__((ext_vector_type(8))) short;
using s16x4  = __attribute__((ext_vector_type(4))) short;
using f32x16 = __attribute__((ext_vector_type(16))) float;
using u32x4  = __attribute__((ext_vector_type(4))) unsigned;
using f32x4  = __attribute__((ext_vector_type(4))) float;
#define KSWZ(row, colB) ((row) * 256 + ((colB) ^ (((row) & 15) << 4)))
#define SBAR() __builtin_amdgcn_sched_barrier(0)
__device__ __forceinline__ int crow(int r, int hi) { return (r & 3) + 8 * (r >> 2) + 4 * hi; }
__device__ __forceinline__ unsigned cvtpk(float lo, float hi) { unsigned r; asm volatile("v_cvt_pk_bf16_f32 %0, %1, %2" : "=v"(r) : "v"(lo), "v"(hi)); return r; }

template <bool FIXM>
__device__ __forceinline__ void partialSM(f32x16& p0, f32x16& p1, float& m_reg, float& mn, float& alpha) {
  constexpr float C = SCALE * 1.4426950408889634f;
  if constexpr (FIXM) { alpha = 1.f;
    return; }
  float pmax = p0[0];
#pragma unroll
  for (int r = 1; r < 16; ++r) pmax = fmaxf(pmax, p0[r]);
#pragma unroll
  for (int r = 0; r < 16; ++r) pmax = fmaxf(pmax, p1[r]);
  { auto rr = __builtin_amdgcn_permlane32_swap(__float_as_uint(pmax), __float_as_uint(pmax), false, false);
    pmax = fmaxf(__uint_as_float(rr[0]), __uint_as_float(rr[1])); }
  if (__builtin_expect(__all(pmax - m_reg <= THR / SCALE), 1)) { mn = m_reg; alpha = 1.f; }
  else { mn = fmaxf(m_reg, pmax); alpha = __builtin_amdgcn_exp2f((m_reg - mn) * C); m_reg = mn; }
  float mnC = -mn * C;
#pragma unroll
  for (int r = 0; r < 16; ++r) p0[r] = fmaf(p0[r], C, mnC);
#pragma unroll
  for (int r = 0; r < 16; ++r) p1[r] = fmaf(p1[r], C, mnC);
#pragma unroll
  for (int r = 0; r < 16; ++r) p0[r] = __builtin_amdgcn_exp2f(p0[r]);
}
template <bool FIXM, bool P0DONE = false>
__device__ __forceinline__ void finishSM(f32x16& p0, f32x16& p1, float alpha, float& l_reg, bf16x8& pa0, bf16x8& pa1, bf16x8& pa2, bf16x8& pa3) {
  if constexpr (FIXM && !P0DONE) {
#pragma unroll
    for (int r = 0; r < 16; ++r) p0[r] = __builtin_amdgcn_exp2f(p0[r]); }
#pragma unroll
  for (int r = 0; r < 16; ++r) p1[r] = __builtin_amdgcn_exp2f(p1[r]);
  float ps = 0;
#pragma unroll
  for (int r = 0; r < 16; ++r) ps += p0[r];
#pragma unroll
  for (int r = 0; r < 16; ++r) ps += p1[r];
  { auto rr = __builtin_amdgcn_permlane32_swap(__float_as_uint(ps), __float_as_uint(ps), false, false);
    ps = __uint_as_float(rr[0]) + __uint_as_float(rr[1]); }
  l_reg = l_reg * alpha + ps;
#define PK4(P, BASE, OUT) do { unsigned a0 = cvtpk(P[BASE + 0], P[BASE + 1]), a1 = cvtpk(P[BASE + 2], P[BASE + 3]);   \
    unsigned b0 = cvtpk(P[BASE + 4], P[BASE + 5]), b1 = cvtpk(P[BASE + 6], P[BASE + 7]);                              \
    auto r0 = __builtin_amdgcn_permlane32_swap(a0, b0, false, false); auto r1 = __builtin_amdgcn_permlane32_swap(a1, b1, false, false); \
    u32x4 w = {r0[0], r1[0], r0[1], r1[1]}; OUT = *reinterpret_cast<bf16x8*>(&w); } while (0)
  PK4(p0, 0, pa0); PK4(p0, 8, pa1); PK4(p1, 0, pa2); PK4(p1, 8, pa3);
#undef PK4
}
__device__ __forceinline__ void qkt(f32x16& p0, f32x16& p1, const bf16* Ks, const bf16x8* qr, int r32, int hi) {
  p0 = f32x16{}; p1 = f32x16{};
#pragma unroll
  for (int d0 = 0; d0 < 8; ++d0) { int cb = (d0 * 16 + hi * 8) * 2;
    bf16x8 b0 = *reinterpret_cast<const bf16x8*>((const char*)Ks + KSWZ(r32, cb));
    bf16x8 b1 = *reinterpret_cast<const bf16x8*>((const char*)Ks + KSWZ(32 + r32, cb));
    p0 = __builtin_amdgcn_mfma_f32_32x32x16_bf16(b0, qr[d0], p0, 0, 0, 0);
    p1 = __builtin_amdgcn_mfma_f32_32x32x16_bf16(b1, qr[d0], p1, 0, 0, 0); }
}
__device__ __forceinline__ int v_st(int k, int c) { const int kk = (k & ~0xC) | ((k & 4) << 1) | ((k & 8) >> 1); return ((kk >> 3) * 4 + (c >> 5)) * 512 + ((kk & 7) * 32 + (c & 31)) * 2; }
__device__ __forceinline__ int v_rd_base(int lane) { return ((lane & 3) << 3) | (((lane >> 2) & 3) << 6) | (((lane >> 4) & 1) << 5) | (((lane >> 5) & 1) << 8); }
constexpr int v_rd_off(int d0, int ks, int half) { return d0 * 512 + ks * 4096 + half * 2048; }
template <int OFF> __device__ __forceinline__ s16x4 tr_read(int vb) {
  s16x4 r; asm volatile("ds_read_b64_tr_b16 %0, %1 offset:%2" : "=&v"(r) : "v"(vb), "i"(OFF) : "memory"); return r;
}
template <int D0> __device__ __forceinline__ void pv_one(f32x16& od, int vb, bf16x8 pa0, bf16x8 pa1, bf16x8 pa2, bf16x8 pa3) {
  const s16x4 l0 = tr_read<v_rd_off(D0, 0, 0)>(vb), h0 = tr_read<v_rd_off(D0, 0, 1)>(vb), l1 = tr_read<v_rd_off(D0, 1, 0)>(vb), h1 = tr_read<v_rd_off(D0, 1, 1)>(vb);
  const s16x4 l2 = tr_read<v_rd_off(D0, 2, 0)>(vb), h2 = tr_read<v_rd_off(D0, 2, 1)>(vb), l3 = tr_read<v_rd_off(D0, 3, 0)>(vb), h3 = tr_read<v_rd_off(D0, 3, 1)>(vb);
  asm volatile("s_waitcnt lgkmcnt(0)" ::: "memory"); SBAR();
#define PK(L, H) (bf16x8){L[0], L[1], L[2], L[3], H[0], H[1], H[2], H[3]}
  od = __builtin_amdgcn_mfma_f32_32x32x16_bf16(pa0, PK(l0, h0), od, 0, 0, 0);
  od = __builtin_amdgcn_mfma_f32_32x32x16_bf16(pa1, PK(l1, h1), od, 0, 0, 0);
  od = __builtin_amdgcn_mfma_f32_32x32x16_bf16(pa2, PK(l2, h2), od, 0, 0, 0);
  od = __builtin_amdgcn_mfma_f32_32x32x16_bf16(pa3, PK(l3, h3), od, 0, 0, 0);
#undef PK
}
template <int D0> __device__ __forceinline__ void pv_one_x(f32x16& od, int vb, bf16x8 pa0, bf16x8 pa1, bf16x8 pa2, bf16x8 pa3, f32x16& px) {
  const s16x4 l0 = tr_read<v_rd_off(D0, 0, 0)>(vb), h0 = tr_read<v_rd_off(D0, 0, 1)>(vb), l1 = tr_read<v_rd_off(D0, 1, 0)>(vb), h1 = tr_read<v_rd_off(D0, 1, 1)>(vb);
  const s16x4 l2 = tr_read<v_rd_off(D0, 2, 0)>(vb), h2 = tr_read<v_rd_off(D0, 2, 1)>(vb), l3 = tr_read<v_rd_off(D0, 3, 0)>(vb), h3 = tr_read<v_rd_off(D0, 3, 1)>(vb);
  asm volatile("s_waitcnt lgkmcnt(0)" ::: "memory"); SBAR();
#define PK(L, H) (bf16x8){L[0], L[1], L[2], L[3], H[0], H[1], H[2], H[3]}
  od = __builtin_amdgcn_mfma_f32_32x32x16_bf16(pa0, PK(l0, h0), od, 0, 0, 0); px[4 * D0 + 0] = __builtin_amdgcn_exp2f(px[4 * D0 + 0]);
  od = __builtin_amdgcn_mfma_f32_32x32x16_bf16(pa1, PK(l1, h1), od, 0, 0, 0); px[4 * D0 + 1] = __builtin_amdgcn_exp2f(px[4 * D0 + 1]);
  od = __builtin_amdgcn_mfma_f32_32x32x16_bf16(pa2, PK(l2, h2), od, 0, 0, 0); px[4 * D0 + 2] = __builtin_amdgcn_exp2f(px[4 * D0 + 2]);
  od = __builtin_amdgcn_mfma_f32_32x32x16_bf16(pa3, PK(l3, h3), od, 0, 0, 0); px[4 * D0 + 3] = __builtin_amdgcn_exp2f(px[4 * D0 + 3]);
#undef PK
}
__device__ __forceinline__ void pv_d0_x(f32x16* o, int vb, bf16x8 pa0, bf16x8 pa1, bf16x8 pa2, bf16x8 pa3, f32x16& px) {
  pv_one_x<0>(o[0], vb, pa0, pa1, pa2, pa3, px); pv_one_x<1>(o[1], vb, pa0, pa1, pa2, pa3, px); pv_one_x<2>(o[2], vb, pa0, pa1, pa2, pa3, px); pv_one_x<3>(o[3], vb, pa0, pa1, pa2, pa3, px);
}
__device__ __forceinline__ void pv_d0(f32x16* o, int vb, bf16x8 pa0, bf16x8 pa1, bf16x8 pa2, bf16x8 pa3) {
  pv_one<0>(o[0], vb, pa0, pa1, pa2, pa3); pv_one<1>(o[1], vb, pa0, pa1, pa2, pa3); pv_one<2>(o[2], vb, pa0, pa1, pa2, pa3); pv_one<3>(o[3], vb, pa0, pa1, pa2, pa3);
}
__device__ __forceinline__ unsigned short f2bf_rne(float f) { unsigned u = __float_as_uint(f); u += 0x7FFFu + ((u >> 16) & 1u); return (unsigned short)(u >> 16); }

#ifndef ATT_SPLITX
#define ATT_SPLITX 0
#endif
#ifndef ATT_STAGGER
#define ATT_STAGGER 0
#endif
template <bool FIXM, int NTT>
__device__ __forceinline__ void attn_unit(const bf16* Qb, const bf16* Kh, const bf16* Vh, bf16* Ob, int seq, char* lds, PG8_LAS unsigned char* ldsl, const int tid, const float mfix,
                                          const float* gqp, const float* tab, const int t0, const float qmul) {
  const int wid = tid >> 6, lane = tid & 63, r32 = lane & 31, hi = lane >> 5;
  constexpr bool RING = FIXM && ATT_RING;
  constexpr int NB = RING ? 3 : 2;
  static_assert(!RING || (NTT % 2 == 0 && (NTT - 1) % 6 == 3), "ring loop: the tile count must leave exactly three steps after the six-step body");
  bf16* V_lds = (bf16*)(RING ? lds + NB * SHM_K : lds); bf16* K_lds = (bf16*)(RING ? lds : lds + NB * SHM_V);
  float* ws = (float*)(lds + NB * SHM_V + NB * SHM_K) + wid * 64; float* li_l = ws; float* al_l = ws + 32;
  float m_reg = FIXM ? mfix : -1e30f, l_reg = 0; f32x16 o[4] = {}; bf16x8 qr[8];
  const bf16* Qw = Qb + (long)(wid * QBLK + r32) * LDQ + hi * 8;
#pragma unroll
  for (int d0 = 0; d0 < 8; ++d0) qr[d0] = *reinterpret_cast<const bf16x8*>(Qw + d0 * 16);
  if constexpr (FIXM) {
    float qf[8][8]; float ss = 0.f;
#pragma unroll
    for (int d0 = 0; d0 < 8; ++d0) { const u32x4 w = __builtin_bit_cast(u32x4, qr[d0]);
      qf[d0][0] = __uint_as_float(w.x << 16); qf[d0][1] = __uint_as_float(w.x & 0xffff0000u); qf[d0][2] = __uint_as_float(w.y << 16); qf[d0][3] = __uint_as_float(w.y & 0xffff0000u);
      qf[d0][4] = __uint_as_float(w.z << 16); qf[d0][5] = __uint_as_float(w.z & 0xffff0000u); qf[d0][6] = __uint_as_float(w.w << 16); qf[d0][7] = __uint_as_float(w.w & 0xffff0000u);
#pragma unroll
      for (int j = 0; j < 8; ++j) ss += qf[d0][j] * qf[d0][j]; }
    { auto rr = __builtin_amdgcn_permlane32_swap(__float_as_uint(ss), __float_as_uint(ss), false, false); ss = __uint_as_float(rr[0]) + __uint_as_float(rr[1]); }
    const float rs = __builtin_amdgcn_rsqf(ss * (1.0f / 128) + 1e-6f) * qmul;
    const int t = t0 + wid * QBLK + r32;
#pragma unroll
    for (int d0 = 0; d0 < 8; ++d0) { const float* gp = gqp + 16 * d0 + 8 * hi; const float4 g0 = *reinterpret_cast<const float4*>(gp), g1 = *reinterpret_cast<const float4*>(gp + 4);
      qf[d0][0] *= rs * g0.x; qf[d0][1] *= rs * g0.y; qf[d0][2] *= rs * g0.z; qf[d0][3] *= rs * g0.w; qf[d0][4] *= rs * g1.x; qf[d0][5] *= rs * g1.y; qf[d0][6] *= rs * g1.z; qf[d0][7] *= rs * g1.w; }
#pragma unroll
    for (int ax = 0; ax < 2; ++ax) { const int pos = ax ? (t & 63) : (t >> 6);
#pragma unroll
      for (int b = 0; b < 2; ++b) { const int da = 4 * ax + b, db = da + 2;
        const float4* tp = reinterpret_cast<const float4*>(tab + (size_t)(pos * 32 + 16 * b + 8 * hi) * 2);
#pragma unroll
        for (int j2 = 0; j2 < 4; ++j2) { const float4 cs = tp[j2];
          { const float x1 = qf[da][2 * j2], x2 = qf[db][2 * j2]; qf[da][2 * j2] = x1 * cs.x - x2 * cs.y; qf[db][2 * j2] = x2 * cs.x + x1 * cs.y; }
          { const float x1 = qf[da][2 * j2 + 1], x2 = qf[db][2 * j2 + 1]; qf[da][2 * j2 + 1] = x1 * cs.z - x2 * cs.w; qf[db][2 * j2 + 1] = x2 * cs.z + x1 * cs.w; } } } }
#pragma unroll
    for (int d0 = 0; d0 < 8; ++d0) { u32x4 w = {cvtpk(qf[d0][0], qf[d0][1]), cvtpk(qf[d0][2], qf[d0][3]), cvtpk(qf[d0][4], qf[d0][5]), cvtpk(qf[d0][6], qf[d0][7])}; qr[d0] = __builtin_bit_cast(bf16x8, w); }
  }
  int sr = tid >> 4; asm volatile("" : "+v"(sr));
  const int sc = (tid & 15) * 8, vst0 = v_st(sr, sc), vst1 = v_st(32 + sr, sc);
  const int vb0 = (int)(uintptr_t)V_lds + v_rd_base(lane);
  f32x16 pA0, pA1, pB0, pB1; bf16x8 pa0, pa1, pa2, pa3;
  if constexpr (RING) {
    const int widu = __builtin_amdgcn_readfirstlane(wid);
    const int krow = 4 * widu + (lane >> 4), kk_ = ((widu >> 1) << 3) | ((lane >> 2) & 7), vkey = (kk_ & ~0xC) | ((kk_ & 4) << 1) | ((kk_ & 8) >> 1);
    const unsigned koff = (unsigned)(krow * LDK + (((lane & 15) ^ (krow & 15)) << 3)) * 2u;
    const unsigned voff = (unsigned)(vkey * LDK + ((((2 * widu + (lane >> 5)) & 3) << 5) + ((lane & 3) << 3)) + (int)(Vh - Kh)) * 2u;
    PG8_LAS unsigned char* const dK = ldsl + widu * 1024; PG8_LAS unsigned char* const dV = ldsl + 3 * SHM_K + widu * 1024;
#define RDMA(b, k0) do { const char* g_ = (const char*)(Kh + (long)(k0) * LDK); const char* g2_ = g_ + 64L * LDK; \
    __builtin_amdgcn_global_load_lds((const unsigned*)(g_ + koff), (PG8_LAS unsigned*)(dK + (b) * SHM_K), 16, 0, 0); \
    __builtin_amdgcn_global_load_lds((const unsigned*)(g2_ + koff), (PG8_LAS unsigned*)(dK + (b) * SHM_K + 8192), 16, 0, 0); \
    __builtin_amdgcn_global_load_lds((const unsigned*)(g_ + voff), (PG8_LAS unsigned*)(dV + (b) * SHM_V), 16, 0, 0); \
    __builtin_amdgcn_global_load_lds((const unsigned*)(g2_ + voff), (PG8_LAS unsigned*)(dV + (b) * SHM_V + 8192), 16, 0, 0); } while (0)
#define RSYNC() do { asm volatile("s_waitcnt vmcnt(0)" ::: "memory"); __syncthreads(); } while (0)
#if ATT_SPLITX
#define RFIN(PO0, PO1) finishSM<true, true>(PO0, PO1, 1.f, l_reg, pa0, pa1, pa2, pa3)
#define RPV(VP, PN0) pv_d0_x(o, vb0 + (VP) * (int)SHM_V, pa0, pa1, pa2, pa3, PN0)
#else
#define RFIN(PO0, PO1) finishSM<true>(PO0, PO1, 1.f, l_reg, pa0, pa1, pa2, pa3)
#define RPV(VP, PN0) pv_d0(o, vb0 + (VP) * (int)SHM_V, pa0, pa1, pa2, pa3)
#endif
#define RSTEP(PN0, PN1, PO0, PO1, KC, VP, WN, WR, T) do { \
    if (WR) { if (!ATT_STAGGER || early) RDMA(WN, ((T) + 1) * KVBLK); } \
    SBAR(); qkt(PN0, PN1, (bf16*)((char*)K_lds + (KC) * SHM_K), qr, r32, hi); \
    RFIN(PO0, PO1); SBAR(); \
    if (WR) { if (ATT_STAGGER && !early) RDMA(WN, ((T) + 1) * KVBLK); } SBAR(); \
    RPV(VP, PN0); \
    RSYNC(); } while (0)
    const bool early = widu < 4;
    __syncthreads();
    RDMA(0, 0); RSYNC();
    RDMA(1, KVBLK); SBAR(); qkt(pA0, pA1, K_lds, qr, r32, hi);
#if ATT_SPLITX
    _Pragma("unroll") for (int r = 0; r < 16; ++r) pA0[r] = __builtin_amdgcn_exp2f(pA0[r]);
#endif
    RSYNC();
    for (int t = 1; t < NTT - 3; t += 6) {
      RSTEP(pB0, pB1, pA0, pA1, 1, 0, 2, true, t);
      RSTEP(pA0, pA1, pB0, pB1, 2, 1, 0, true, t + 1);
      RSTEP(pB0, pB1, pA0, pA1, 0, 2, 1, true, t + 2);
      RSTEP(pA0, pA1, pB0, pB1, 1, 0, 2, true, t + 3);
      RSTEP(pB0, pB1, pA0, pA1, 2, 1, 0, true, t + 4);
      RSTEP(pA0, pA1, pB0, pB1, 0, 2, 1, true, t + 5);
    }
    RSTEP(pB0, pB1, pA0, pA1, 1, 0, 2, true, NTT - 3);
    RSTEP(pA0, pA1, pB0, pB1, 2, 1, 0, true, NTT - 2);
    RSTEP(pB0, pB1, pA0, pA1, 0, 2, 1, false, NTT - 1);
    RFIN(pB0, pB1); SBAR();
    pv_d0(o, vb0, pa0, pa1, pa2, pa3);
#undef RDMA
#undef RSYNC
#undef RSTEP
#undef RFIN
#undef RPV
  } else {
  constexpr int SDEPTH = FIXM ? ATT_SDEPTH_FIX : 2;
  struct { bf16x8 vs0, vs1, ks0, ks1; } sr_[SDEPTH];
#define SLOAD(i, k0) do { sr_[i].vs0 = *reinterpret_cast<const bf16x8*>(&Vh[(long)((k0) + sr) * LDK + sc]); sr_[i].vs1 = *reinterpret_cast<const bf16x8*>(&Vh[(long)((k0) + 32 + sr) * LDK + sc]); \
    sr_[i].ks0 = *reinterpret_cast<const bf16x8*>(&Kh[(long)((k0) + sr) * LDK + sc]); sr_[i].ks1 = *reinterpret_cast<const bf16x8*>(&Kh[(long)((k0) + 32 + sr) * LDK + sc]); } while (0)
#define SWRITE(b, i) do { *(bf16x8*)((char*)V_lds + (b) * SHM_V + vst0) = sr_[i].vs0;          \
    *(bf16x8*)((char*)V_lds + (b) * SHM_V + vst1) = sr_[i].vs1; int kc = sc * 2;               \
    *(bf16x8*)((char*)K_lds + (b) * SHM_K + KSWZ(sr, kc)) = sr_[i].ks0;                       \
    *(bf16x8*)((char*)K_lds + (b) * SHM_K + KSWZ(32 + sr, kc)) = sr_[i].ks1; } while (0)
#define SWAIT() do { if constexpr (SDEPTH == 2) asm volatile("s_waitcnt vmcnt(4)" ::: "memory"); else asm volatile("s_waitcnt vmcnt(0)" ::: "memory"); } while (0)
#define RESC(a) do { if (!FIXM && __any((a) < 1.f)) { if (hi == 0) al_l[r32] = (a); asm volatile("s_waitcnt lgkmcnt(0)" ::: "memory"); \
    _Pragma("unroll") for (int d = 0; d < 4; ++d) _Pragma("unroll") for (int r = 0; r < 16; ++r) o[d][r] *= al_l[crow(r, hi)]; } } while (0)
  float mnA, mnB, alA, alB; const int NT = seq / KVBLK;
  constexpr int SE = 0, SO = SDEPTH - 1;
  SLOAD(SE, 0); asm volatile("s_waitcnt vmcnt(0)" ::: "memory"); SWRITE(0, SE); __syncthreads();
  qkt(pA0, pA1, K_lds, qr, r32, hi); partialSM<FIXM>(pA0, pA1, m_reg, mnA, alA);
  SLOAD(SO, KVBLK); if constexpr (SDEPTH == 2) { if (2 < NT) SLOAD(SE, 2 * KVBLK); }
  SWAIT(); SWRITE(1, SO); __syncthreads();
  for (int j = 1; j + 1 < NT; j += 2) {
    SBAR(); qkt(pB0, pB1, (bf16*)((char*)K_lds + SHM_K), qr, r32, hi);
    finishSM<FIXM>(pA0, pA1, alA, l_reg, pa0, pa1, pa2, pa3); SBAR();
    SLOAD(SO, (j + SDEPTH) * KVBLK); SBAR();
    pv_d0(o, vb0, pa0, pa1, pa2, pa3); partialSM<FIXM>(pB0, pB1, m_reg, mnB, alB);
    __syncthreads(); SWAIT(); SWRITE(0, SE);
    RESC(alB); __syncthreads();
    SBAR(); qkt(pA0, pA1, K_lds, qr, r32, hi);
    finishSM<FIXM>(pB0, pB1, alB, l_reg, pa0, pa1, pa2, pa3); SBAR();
    if (SDEPTH == 1 || j + 3 < NT) SLOAD(SE, (j + 1 + SDEPTH) * KVBLK); SBAR();
    pv_d0(o, vb0 + (int)SHM_V, pa0, pa1, pa2, pa3); partialSM<FIXM>(pA0, pA1, m_reg, mnA, alA);
    __syncthreads(); SWAIT(); SWRITE(1, SO);
    RESC(alA); __syncthreads();
  }
  SBAR(); qkt(pB0, pB1, (bf16*)((char*)K_lds + SHM_K), qr, r32, hi);
  finishSM<FIXM>(pA0, pA1, alA, l_reg, pa0, pa1, pa2, pa3); SBAR();
  pv_d0(o, vb0, pa0, pa1, pa2, pa3); partialSM<FIXM>(pB0, pB1, m_reg, mnB, alB);
  __syncthreads(); RESC(alB);
  finishSM<FIXM>(pB0, pB1, alB, l_reg, pa0, pa1, pa2, pa3); SBAR();
  pv_d0(o, vb0 + (int)SHM_V, pa0, pa1, pa2, pa3);
  }
  if (hi == 0) li_l[r32] = l_reg; asm volatile("s_waitcnt lgkmcnt(0)" ::: "memory");
  float rli[16];
#pragma unroll
  for (int r = 0; r < 16; ++r) rli[r] = __builtin_amdgcn_rcpf(li_l[crow(r, hi)]);
  const int odd = r32 & 1; bf16* Ow = Ob + (long)(wid * QBLK + 4 * hi + odd) * LDO + (r32 & ~1);
  asm volatile("" : "+v"(Ow));
#pragma unroll
  for (int d0 = 0; d0 < 4; ++d0)
#pragma unroll
    for (int i = 0; i < 8; ++i) { float v0 = o[d0][2 * i] * rli[2 * i], v1 = o[d0][2 * i + 1] * rli[2 * i + 1];
      asm volatile("" : "+v"(v0), "+v"(v1));
      const float send = odd ? v0 : v1;
      const float recv = __builtin_bit_cast(float, __builtin_amdgcn_update_dpp(0, __builtin_bit_cast(int, send), 0xB1, 0xF, 0xF, true));
      const unsigned w = cvtpk(odd ? recv : v0, odd ? v1 : recv);
      *(unsigned*)(Ow + (long)(((2 * i) & 3) + 8 * ((2 * i) >> 2)) * LDO + d0 * 32) = w; }
#undef SLOAD
#undef SWRITE
#undef SWAIT
#undef RESC
}

struct S16 { f32x4 t[4][2]; };
template <int OFF> __device__ __forceinline__ bf16x8 k_read(int a) { bf16x8 r; asm volatile("ds_read_b128 %0, %1 offset:%2" : "=&v"(r) : "v"(a), "i"(OFF) : "memory"); return r; }
typedef __bf16 bf16x2_n __attribute__((ext_vector_type(2))); typedef float f32x2_n __attribute__((ext_vector_type(2)));
__device__ __forceinline__ unsigned cvtpk_n(float lo, float hi) { const f32x2_n v = {lo, hi}; return __builtin_bit_cast(unsigned, __builtin_convertvector(v, bf16x2_n)); }
template <int KT> __device__ __forceinline__ void fin16_part(S16& p, float (&l)[2], bf16x8 (&pb)[2][2]) {
#pragma unroll
  for (int qt = 0; qt < 2; ++qt)
#pragma unroll
    for (int r = 0; r < 4; ++r) { p.t[KT][qt][r] = __builtin_amdgcn_exp2f(p.t[KT][qt][r]); l[qt] += p.t[KT][qt][r]; }
  if constexpr (KT & 1) {
#pragma unroll
    for (int qt = 0; qt < 2; ++qt) { const f32x4 a = p.t[KT - 1][qt], b = p.t[KT][qt];
      u32x4 w = {cvtpk_n(a[0], a[1]), cvtpk_n(a[2], a[3]), cvtpk_n(b[0], b[1]), cvtpk_n(b[2], b[3])}; pb[qt][KT >> 1] = __builtin_bit_cast(bf16x8, w); } }
}
__device__ __forceinline__ void finish16(S16& p, float (&l)[2], bf16x8 (&pb)[2][2]) { fin16_part<0>(p, l, pb); fin16_part<1>(p, l, pb); fin16_part<2>(p, l, pb); fin16_part<3>(p, l, pb); }
#define QK16_MMA(F, KS) do { _Pragma("unroll") for (int kt = 0; kt < 4; ++kt) { \
    s.t[kt][0] = __builtin_amdgcn_mfma_f32_16x16x32_bf16(F[kt], qr[0][KS], s.t[kt][0], 0, 0, 0); \
    s.t[kt][1] = __builtin_amdgcn_mfma_f32_16x16x32_bf16(F[kt], qr[1][KS], s.t[kt][1], 0, 0, 0); } } while (0)
#define QK16_RD(F, KS) do { F[0] = k_read<KC * 16384>(ka[KS]); F[1] = k_read<KC * 16384 + 4096>(ka[KS]); F[2] = k_read<KC * 16384 + 8192>(ka[KS]); F[3] = k_read<KC * 16384 + 12288>(ka[KS]); } while (0)
#define QK16_WAIT(F) do { asm volatile("s_waitcnt lgkmcnt(0)" : "+v"(F[0]), "+v"(F[1]), "+v"(F[2]), "+v"(F[3]), "+v"(s.t[0][0]), "+v"(s.t[0][1]), "+v"(s.t[1][0]), "+v"(s.t[1][1]), \
    "+v"(s.t[2][0]), "+v"(s.t[2][1]), "+v"(s.t[3][0]), "+v"(s.t[3][1]) :: "memory"); SBAR(); } while (0)
template <int KC, bool FIN> __device__ __forceinline__ void qk16(S16& s, S16& po, float (&l)[2], bf16x8 (&pb)[2][2], const int (&ka)[4], const bf16x8 (&qr)[2][4]) {
  bf16x8 f0[4], f1[4];
  QK16_RD(f0, 0);
#pragma unroll
  for (int kt = 0; kt < 4; ++kt) { s.t[kt][0] = (f32x4){0.f, 0.f, 0.f, 0.f}; s.t[kt][1] = (f32x4){0.f, 0.f, 0.f, 0.f}; }
  QK16_WAIT(f0); QK16_RD(f1, 1); QK16_MMA(f0, 0); if constexpr (FIN) fin16_part<0>(po, l, pb);
  QK16_WAIT(f1); QK16_RD(f0, 2); QK16_MMA(f1, 1); if constexpr (FIN) fin16_part<1>(po, l, pb);
  QK16_WAIT(f0); QK16_RD(f1, 3); QK16_MMA(f0, 2); if constexpr (FIN) fin16_part<2>(po, l, pb);
  QK16_WAIT(f1);                 QK16_MMA(f1, 3); if constexpr (FIN) fin16_part<3>(po, l, pb);
}
#undef QK16_MMA
#undef QK16_RD
#undef QK16_WAIT
template <int DT0> __device__ __forceinline__ void pv16_two(f32x4 (&o)[8][2], int vb, const bf16x8 (&pb)[2][2]) {
  const s16x4 a00 = tr_read<0 * 4096 + DT0 * 256>(vb), a01 = tr_read<1 * 4096 + DT0 * 256>(vb), a10 = tr_read<2 * 4096 + DT0 * 256>(vb), a11 = tr_read<3 * 4096 + DT0 * 256>(vb);
  const s16x4 b00 = tr_read<0 * 4096 + DT0 * 256 + 256>(vb), b01 = tr_read<1 * 4096 + DT0 * 256 + 256>(vb), b10 = tr_read<2 * 4096 + DT0 * 256 + 256>(vb), b11 = tr_read<3 * 4096 + DT0 * 256 + 256>(vb);
  asm volatile("s_waitcnt lgkmcnt(0)" ::: "memory"); SBAR();
#define PK(L, H) (bf16x8){L[0], L[1], L[2], L[3], H[0], H[1], H[2], H[3]}
  o[DT0][0] = __builtin_amdgcn_mfma_f32_16x16x32_bf16(PK(a00, a01), pb[0][0], o[DT0][0], 0, 0, 0);
  o[DT0][1] = __builtin_amdgcn_mfma_f32_16x16x32_bf16(PK(a00, a01), pb[1][0], o[DT0][1], 0, 0, 0);
  o[DT0 + 1][0] = __builtin_amdgcn_mfma_f32_16x16x32_bf16(PK(b00, b01), pb[0][0], o[DT0 + 1][0], 0, 0, 0);
  o[DT0 + 1][1] = __builtin_amdgcn_mfma_f32_16x16x32_bf16(PK(b00, b01), pb[1][0], o[DT0 + 1][1], 0, 0, 0);
  o[DT0][0] = __builtin_amdgcn_mfma_f32_16x16x32_bf16(PK(a10, a11), pb[0][1], o[DT0][0], 0, 0, 0);
  o[DT0][1] = __builtin_amdgcn_mfma_f32_16x16x32_bf16(PK(a10, a11), pb[1][1], o[DT0][1], 0, 0, 0);
  o[DT0 + 1][0] = __builtin_amdgcn_mfma_f32_16x16x32_bf16(PK(b10, b11), pb[0][1], o[DT0 + 1][0], 0, 0, 0);
  o[DT0 + 1][1] = __builtin_amdgcn_mfma_f32_16x16x32_bf16(PK(b10, b11), pb[1][1], o[DT0 + 1][1], 0, 0, 0);
#undef PK
}
__device__ __forceinline__ void pv16(f32x4 (&o)[8][2], int vb, const bf16x8 (&pb)[2][2]) { pv16_two<0>(o, vb, pb); pv16_two<2>(o, vb, pb); pv16_two<4>(o, vb, pb); pv16_two<6>(o, vb, pb); }
__device__ __forceinline__ float sum4groups(float v) {
  v += __builtin_bit_cast(float, __builtin_amdgcn_ds_swizzle(__builtin_bit_cast(int, v), 0x401F));
  auto rr = __builtin_amdgcn_permlane32_swap(__float_as_uint(v), __float_as_uint(v), false, false);
  return __uint_as_float(rr[0]) + __uint_as_float(rr[1]);
}
template <int NTT>
__device__ __forceinline__ void attn_unit16(const bf16* Qb, const bf16* Kh, const bf16* Vh, bf16* Ob, char* lds, PG8_LAS unsigned char* ldsl, const int tid,
                                            const float* gqp, const float* tab, const int t0, const float qmul) {
  static_assert(NTT % 2 == 0 && (NTT - 1) % 6 == 3, "ring loop: the tile count must leave exactly three steps after the six-step body");
  int tl = tid; asm volatile("" : "+v"(tl));
  const int wid = tl >> 6, lane = tl & 63, li = lane & 15, lg = lane >> 4;
  char* const K_lds = lds;
  float l_reg[2] = {0.f, 0.f}; f32x4 o[8][2]; bf16x8 qr[2][4];
#pragma unroll
  for (int dt = 0; dt < 8; ++dt) { o[dt][0] = (f32x4){0.f, 0.f, 0.f, 0.f}; o[dt][1] = (f32x4){0.f, 0.f, 0.f, 0.f}; }
#pragma unroll
  for (int qt = 0; qt < 2; ++qt) { const bf16* Qw = Qb + (long)(wid * QBLK + 16 * qt + li) * LDQ + 8 * lg;
#pragma unroll
    for (int ks = 0; ks < 4; ++ks) qr[qt][ks] = *reinterpret_cast<const bf16x8*>(Qw + 32 * ks); }
#pragma unroll
  for (int qt = 0; qt < 2; ++qt) { float qf[4][8]; float ss = 0.f;
#pragma unroll
    for (int ks = 0; ks < 4; ++ks) { const u32x4 w = __builtin_bit_cast(u32x4, qr[qt][ks]);
      qf[ks][0] = __uint_as_float(w.x << 16); qf[ks][1] = __uint_as_float(w.x & 0xffff0000u); qf[ks][2] = __uint_as_float(w.y << 16); qf[ks][3] = __uint_as_float(w.y & 0xffff0000u);
      qf[ks][4] = __uint_as_float(w.z << 16); qf[ks][5] = __uint_as_float(w.z & 0xffff0000u); qf[ks][6] = __uint_as_float(w.w << 16); qf[ks][7] = __uint_as_float(w.w & 0xffff0000u);
#pragma unroll
      for (int j = 0; j < 8; ++j) ss += qf[ks][j] * qf[ks][j]; }
    ss = sum4groups(ss);
    const float rs = __builtin_amdgcn_rsqf(ss * (1.0f / 128) + 1e-6f) * qmul;
    const int t = t0 + wid * QBLK + 16 * qt + li;
#pragma unroll
    for (int ks = 0; ks < 4; ++ks) { const float* gp = gqp + 32 * ks + 8 * lg; const float4 g0 = *reinterpret_cast<const float4*>(gp), g1 = *reinterpret_cast<const float4*>(gp + 4);
      qf[ks][0] *= rs * g0.x; qf[ks][1] *= rs * g0.y; qf[ks][2] *= rs * g0.z; qf[ks][3] *= rs * g0.w; qf[ks][4] *= rs * g1.x; qf[ks][5] *= rs * g1.y; qf[ks][6] *= rs * g1.z; qf[ks][7] *= rs * g1.w; }
#pragma unroll
    for (int ax = 0; ax < 2; ++ax) { const int pos = ax ? (t & 63) : (t >> 6); const int da = 2 * ax, db = da + 1;
      const float4* tp = reinterpret_cast<const float4*>(tab + (size_t)(pos * 32 + 8 * lg) * 2);
#pragma unroll
      for (int j2 = 0; j2 < 4; ++j2) { const float4 cs = tp[j2];
        { const float x1 = qf[da][2 * j2], x2 = qf[db][2 * j2]; qf[da][2 * j2] = x1 * cs.x - x2 * cs.y; qf[db][2 * j2] = x2 * cs.x + x1 * cs.y; }
        { const float x1 = qf[da][2 * j2 + 1], x2 = qf[db][2 * j2 + 1]; qf[da][2 * j2 + 1] = x1 * cs.z - x2 * cs.w; qf[db][2 * j2 + 1] = x2 * cs.z + x1 * cs.w; } } }
#pragma unroll
    for (int ks = 0; ks < 4; ++ks) { u32x4 w = {cvtpk(qf[ks][0], qf[ks][1]), cvtpk(qf[ks][2], qf[ks][3]), cvtpk(qf[ks][4], qf[ks][5]), cvtpk(qf[ks][6], qf[ks][7])}; qr[qt][ks] = __builtin_bit_cast(bf16x8, w); } }
  int ka[4];
#pragma unroll
  for (int ks = 0; ks < 4; ++ks) ka[ks] = (int)(uintptr_t)K_lds + li * 256 + ((64 * ks + 16 * lg) ^ (16 * li));
  const int vb0 = (int)(uintptr_t)(lds + 3 * SHM_K) + (lg >> 1) * 2048 + (4 * (lg & 1) + ((lane >> 2) & 3)) * 32 + 8 * (lane & 3);
  S16 pA, pB; bf16x8 pb[2][2];
  const int widu = __builtin_amdgcn_readfirstlane(wid);
  const int krow = 4 * widu + (lane >> 4), vrow = 8 * (widu >> 1) + ((lane >> 1) & 7), vd = 16 * ((4 * widu + (lane >> 4)) & 7) + 8 * (lane & 1);
  const unsigned koff = (unsigned)(krow * LDK + (((lane & 15) ^ (krow & 15)) << 3)) * 2u;
  const unsigned voff = (unsigned)(vrow * LDK + vd + (int)(Vh - Kh)) * 2u;
  PG8_LAS unsigned char* const dK = ldsl + widu * 1024; PG8_LAS unsigned char* const dV = ldsl + 3 * SHM_K + widu * 1024;
#define RDMA(b, k0) do { const char* g_ = (const char*)(Kh + (long)(k0) * LDK); const char* g2_ = g_ + 64L * LDK; \
    __builtin_amdgcn_global_load_lds((const unsigned*)(g_ + koff), (PG8_LAS unsigned*)(dK + (b) * SHM_K), 16, 0, 0); \
    __builtin_amdgcn_global_load_lds((const unsigned*)(g2_ + koff), (PG8_LAS unsigned*)(dK + (b) * SHM_K + 8192), 16, 0, 0); \
    __builtin_amdgcn_global_load_lds((const unsigned*)(g_ + voff), (PG8_LAS unsigned*)(dV + (b) * SHM_V), 16, 0, 0); \
    __builtin_amdgcn_global_load_lds((const unsigned*)(g2_ + voff), (PG8_LAS unsigned*)(dV + (b) * SHM_V + 8192), 16, 0, 0); } while (0)
#define RSYNC() do { asm volatile("s_waitcnt vmcnt(0)" ::: "memory"); __syncthreads(); } while (0)
#define RSTEP(PN, PO, KC, VP, WN, WR, T) do { \
    if (WR) RDMA(WN, ((T) + 1) * KVBLK); \
    SBAR(); qk16<KC, true>(PN, PO, l_reg, pb, ka, qr); SBAR(); \
    pv16(o, vb0 + (VP) * (int)SHM_V, pb); \
    RSYNC(); } while (0)
  __syncthreads();
  RDMA(0, 0); RSYNC();
  RDMA(1, KVBLK); SBAR(); qk16<0, false>(pA, pB, l_reg, pb, ka, qr); RSYNC();
  for (int t = 1; t < NTT - 3; t += 6) {
    RSTEP(pB, pA, 1, 0, 2, true, t);
    RSTEP(pA, pB, 2, 1, 0, true, t + 1);
    RSTEP(pB, pA, 0, 2, 1, true, t + 2);
    RSTEP(pA, pB, 1, 0, 2, true, t + 3);
    RSTEP(pB, pA, 2, 1, 0, true, t + 4);
    RSTEP(pA, pB, 0, 2, 1, true, t + 5);
  }
  RSTEP(pB, pA, 1, 0, 2, true, NTT - 3);
  RSTEP(pA, pB, 2, 1, 0, true, NTT - 2);
  RSTEP(pB, pA, 0, 2, 1, false, NTT - 1);
  finish16(pB, l_reg, pb); SBAR();
  pv16(o, vb0, pb);
#undef RDMA
#undef RSYNC
#undef RSTEP
  const float rl0 = __builtin_amdgcn_rcpf(sum4groups(l_reg[0])), rl1 = __builtin_amdgcn_rcpf(sum4groups(l_reg[1]));
  bf16* Ow = Ob + (long)(wid * QBLK + li) * LDO + 4 * lg;
  asm volatile("" : "+v"(Ow));
#pragma unroll
  for (int dt = 0; dt < 8; ++dt)
#pragma unroll
    for (int qt = 0; qt < 2; ++qt) { const f32x4 v = o[dt][qt] * (qt ? rl1 : rl0);
      uint2 w; w.x = cvtpk(v[0], v[1]); w.y = cvtpk(v[2], v[3]);
      *reinterpret_cast<uint2*>(Ow + (long)(16 * qt) * LDO + 16 * dt) = w; }
}
}

constexpr int NWAVES = 8;
constexpr int DM = 2048, DFF = 5632, NGU = 2 * DFF, INW = 3584, ATTW = 1024, RNNW = 1024;
constexpr int MH = 32768;
constexpr int ZQ = 0, ZK = 1024, ZV = 1280, ZXR = 1536, ZYR = 2560;
constexpr float EPS = 1e-6f;
constexpr int LC = 256;
constexpr int NCHUNK = MH / LC;
constexpr size_t MiB = 1u << 20;
constexpr size_t WS_CTL = 0, CTL_ZERO_BYTES = 1 * MiB;
constexpr size_t WS_ROPE = 1 * MiB;
constexpr size_t WS_SUM = 2 * MiB;
constexpr size_t WS_CIN = 4 * MiB;
constexpr size_t WS_RS = 5 * MiB;
constexpr size_t WS_WGU1 = 8 * MiB, WS_WD1 = 52 * MiB, WS_WIN = 74 * MiB, WS_WOUT = 88 * MiB, WS_WGU2 = 96 * MiB, WS_WD2 = 140 * MiB;
constexpr size_t WS_XN = 162 * MiB;
constexpr size_t WS_Y = 290 * MiB;
constexpr size_t WS_H = 418 * MiB;
constexpr size_t WS_Z = WS_H, WS_HLB = WS_H + 224 * MiB, WS_PRB = WS_H + 288 * MiB;
constexpr size_t WS_HLF = WS_Y, WS_PRF = WS_Y + 64 * MiB;
constexpr size_t WS_MIX = 770 * MiB;
constexpr size_t WS_END = 898 * MiB;
static_assert(WS_WGU1 + (size_t)NGU * DM * 2 <= WS_WD1 && WS_WD1 + (size_t)DM * DFF * 2 <= WS_WIN && WS_WIN + (size_t)INW * DM * 2 <= WS_WOUT && WS_WOUT + (size_t)DM * DM * 2 <= WS_WGU2 &&
              WS_WGU2 + (size_t)NGU * DM * 2 <= WS_WD2 && WS_WD2 + (size_t)DM * DFF * 2 <= WS_XN && WS_XN + (size_t)MH * DM * 2 <= WS_Y && WS_Y + (size_t)MH * DM * 2 <= WS_H &&
              WS_H + (size_t)MH * DFF * 2 <= WS_MIX && WS_MIX + (size_t)MH * DM * 2 <= WS_END && WS_Z + (size_t)MH * INW * 2 <= WS_HLB && WS_PRB + (size_t)MH * RNNW * 2 <= WS_MIX && WS_PRF + (size_t)MH * RNNW * 2 <= WS_H, "d_ws map");
constexpr int CW_TMO = 0, CW_CODE = 1;
constexpr int CW_BAR = 4096;
constexpr int RING_OFF = 0, RING_BYTES = 131072;
constexpr int LDSCTL_OFF = RING_BYTES, MISC_OFF = LDSCTL_OFF + 320;
constexpr int LDS_BYTES = 147456;
static_assert(MISC_OFF + 128 <= LDS_BYTES, "LDS map");

#define GAS __attribute__((address_space(1)))
#define LAS __attribute__((address_space(3)))
typedef unsigned short bf16;
typedef unsigned v4u __attribute__((ext_vector_type(4)));
typedef unsigned v2u __attribute__((ext_vector_type(2)));
typedef float f32x4 __attribute__((ext_vector_type(4)));
typedef float f32x2 __attribute__((ext_vector_type(2)));
typedef float f32x16 __attribute__((ext_vector_type(16)));
typedef short bf16x8 __attribute__((ext_vector_type(8)));
typedef GAS unsigned gu32;
#define RLX_AGENT __ATOMIC_RELAXED, __HIP_MEMORY_SCOPE_AGENT
#define LDS_WAIT() asm volatile("s_waitcnt lgkmcnt(0)" ::: "memory")
#define VM_WAIT() asm volatile("s_waitcnt vmcnt(0)" ::: "memory")
__device__ __forceinline__ unsigned pk2(float lo, float hi) { unsigned r; asm volatile("v_cvt_pk_bf16_f32 %0, %1, %2" : "=v"(r) : "v"(lo), "v"(hi)); return r; }
__device__ __forceinline__ float bflo(unsigned w) { return __uint_as_float(w << 16); }
__device__ __forceinline__ float bfhi(unsigned w) { return __uint_as_float(w & 0xffff0000u); }

#define XB_TMO      128
#define XB_XCNT(j)  (256  + 64 * (j))
#define XB_XSUB(j)  (1280 + 64 * (j))
#define XB_XGEN(j)  (2304 + 64 * (j))
#define XB_TOP      3328
#define XB_TOPGEN   3392
#define XCD_BAR_WORDS 3456
#define XB_SPIN_CAP (1u << 18)
__device__ __forceinline__ unsigned xb_ld(unsigned* p)              { return __hip_atomic_load(p, __ATOMIC_RELAXED, __HIP_MEMORY_SCOPE_AGENT); }
__device__ __forceinline__ unsigned xb_add(unsigned* p, unsigned v) { return __hip_atomic_fetch_add(p, v, __ATOMIC_RELAXED, __HIP_MEMORY_SCOPE_AGENT); }
__device__ __forceinline__ unsigned xb_xcc_id() { return (unsigned)__builtin_amdgcn_s_getreg((3 << 11) | 20) & 0xFu; }
#define XB_SPIN(cond, bar) do { unsigned _sp = 0; while (cond) { __builtin_amdgcn_s_sleep(1); \
    if ((++_sp & 255u) == 0u) { if (xb_ld(&(bar)[XB_TMO])) break; if (_sp > XB_SPIN_CAP) { atomicAdd(&(bar)[XB_TMO], 1u); break; } } } } while (0)
__device__ __forceinline__ int lane_id() { return (int)__builtin_amdgcn_mbcnt_hi(~0u, __builtin_amdgcn_mbcnt_lo(~0u, 0u)); }
struct XcdBarrier { unsigned* bar; unsigned x; volatile LAS unsigned* st; int wv; };
__device__ __forceinline__ XcdBarrier xcd_barrier_post(unsigned* bar, volatile LAS unsigned* st, int wv) {
    XcdBarrier b; b.bar = bar; b.x = xb_xcc_id(); b.st = st; b.wv = wv;
    if (wv == 0 && lane_id() == 0) (void)xb_add(&bar[XB_XCNT(b.x)], 1u);
    return b;
}
__device__ __forceinline__ void xcd_barrier_complete(unsigned* bar, unsigned x, unsigned& nloc, unsigned& nx) {
    const unsigned G = gridDim.x * gridDim.y * gridDim.z;
    unsigned sum, cnt, mine, sp = 0u;
    for (;;) {
        sum = 0u; cnt = 0u; mine = 0u;
#pragma unroll
        for (unsigned j = 0; j < 16; ++j) { const unsigned c = xb_ld(&bar[XB_XCNT(j)]); sum += c; cnt += (c > 0u) ? 1u : 0u; mine = (j == x) ? c : mine; }
        if (sum == G) break;
        __builtin_amdgcn_s_sleep(1);
        if ((++sp & 255u) == 0u) { if (xb_ld(&bar[XB_TMO])) break; if (sp > XB_SPIN_CAP) { atomicAdd(&bar[XB_TMO], 1u); break; } }
    }
    nloc = mine > 0u ? mine : 1u; nx = cnt > 0u ? cnt : 1u;
}
__device__ __forceinline__ void xcd_barrier(const XcdBarrier& b) {
    asm volatile("s_waitcnt vmcnt(0)" ::: "memory");
    __syncthreads();
    if (b.wv == 0 && lane_id() == 0) {
        unsigned* bar = b.bar;
        __builtin_amdgcn_s_waitcnt(0);
        unsigned nloc = b.st[0], nx = b.st[1];
        if (nloc == 0u) { xcd_barrier_complete(bar, b.x, nloc, nx); b.st[0] = nloc; b.st[1] = nx; }
        const unsigned old = xb_add(&bar[XB_XSUB(b.x)], 1u);
        const unsigned gen = old / nloc;
        if (old + 1u == (gen + 1u) * nloc) {
            __builtin_amdgcn_fence(__ATOMIC_RELEASE, "agent");
            asm volatile("s_waitcnt vmcnt(0)" ::: "memory");
            const unsigned og = xb_add(&bar[XB_TOP], 1u);
            const unsigned tg = og / nx;
            if (og + 1u == (tg + 1u) * nx) xb_add(&bar[XB_TOPGEN], 1u);
            else XB_SPIN(xb_ld(&bar[XB_TOPGEN]) == tg, bar);
            __builtin_amdgcn_fence(__ATOMIC_ACQUIRE, "agent");
            xb_add(&bar[XB_XGEN(b.x)], 1u);
            asm volatile("s_waitcnt vmcnt(0)" ::: "memory");
        } else {
            XB_SPIN(xb_ld(&bar[XB_XGEN(b.x)]) == gen, bar);
            __builtin_amdgcn_fence(__ATOMIC_ACQUIRE, "agent");
            asm volatile("s_waitcnt vmcnt(0)" ::: "memory");
        }
    }
    __syncthreads();
}

struct Args { unsigned long long in[32]; unsigned long long out, ws; int ph_lo, ph_hi; };
typedef const __attribute__((address_space(4))) Args* ArgP;
__device__ __forceinline__ ArgP argp() { ArgP p = (ArgP)__builtin_amdgcn_kernarg_segment_ptr(); asm volatile("" : "+s"(p)); return p; }
__device__ __forceinline__ const float* inp(ArgP A, int k) { return (const float*)(const GAS float*)A->in[k]; }
__device__ __forceinline__ float* outp(ArgP A) { return (float*)(GAS float*)A->out; }
template <class T> __device__ __forceinline__ T* wsp(ArgP A, size_t off) { return (T*)(GAS T*)(A->ws + off); }
struct Frame {
    LAS unsigned char* lds;
    int tid, lane, wave;
    int bid, G;
    int gw, NGW;
};
template <int TAG = 0> __device__ __forceinline__ Frame mkframe(unsigned char* lds, int wv) {
    Frame F; F.lds = (LAS unsigned char*)lds;
    int t; asm volatile("v_mbcnt_lo_u32_b32 %0, -1, 0\n\tv_mbcnt_hi_u32_b32 %0, -1, %0\n\tv_lshl_add_u32 %0, %1, 6, %0 ; frame %2" : "=&v"(t) : "s"(wv), "i"(TAG));
    int b = blockIdx.x; asm volatile("; frame %1" : "+s"(b) : "i"(TAG)); int g = gridDim.x; asm volatile("; frame %1" : "+s"(g) : "i"(TAG));
    F.tid = t; F.lane = t & 63; F.wave = __builtin_amdgcn_readfirstlane(t >> 6); F.bid = b; F.G = g; F.gw = b * NWAVES + F.wave; F.NGW = g * NWAVES;
    return F;
}
__device__ __forceinline__ float wave_sum(float v) {
    v += __builtin_bit_cast(float, __builtin_amdgcn_update_dpp(0, __builtin_bit_cast(int, v), 0xB1, 0xF, 0xF, true));
    v += __builtin_bit_cast(float, __builtin_amdgcn_update_dpp(0, __builtin_bit_cast(int, v), 0x4E, 0xF, 0xF, true));
    v += __builtin_bit_cast(float, __builtin_amdgcn_update_dpp(0, __builtin_bit_cast(int, v), 0x141, 0xF, 0xF, true));
    v += __builtin_bit_cast(float, __builtin_amdgcn_update_dpp(0, __builtin_bit_cast(int, v), 0x140, 0xF, 0xF, true));
    const int iv = __builtin_bit_cast(int, v);
    return (__builtin_bit_cast(float, __builtin_amdgcn_readlane(iv, 0)) + __builtin_bit_cast(float, __builtin_amdgcn_readlane(iv, 16))) +
           (__builtin_bit_cast(float, __builtin_amdgcn_readlane(iv, 32)) + __builtin_bit_cast(float, __builtin_amdgcn_readlane(iv, 48)));
}
__device__ __forceinline__ float wave_max(float v) {
    v = fmaxf(v, __builtin_bit_cast(float, __builtin_amdgcn_update_dpp(0, __builtin_bit_cast(int, v), 0xB1, 0xF, 0xF, true)));
    v = fmaxf(v, __builtin_bit_cast(float, __builtin_amdgcn_update_dpp(0, __builtin_bit_cast(int, v), 0x4E, 0xF, 0xF, true)));
    v = fmaxf(v, __builtin_bit_cast(float, __builtin_amdgcn_update_dpp(0, __builtin_bit_cast(int, v), 0x141, 0xF, 0xF, true)));
    v = fmaxf(v, __builtin_bit_cast(float, __builtin_amdgcn_update_dpp(0, __builtin_bit_cast(int, v), 0x140, 0xF, 0xF, true)));
    const int iv = __builtin_bit_cast(int, v);
    return fmaxf(fmaxf(__builtin_bit_cast(float, __builtin_amdgcn_readlane(iv, 0)), __builtin_bit_cast(float, __builtin_amdgcn_readlane(iv, 16))),
                 fmaxf(__builtin_bit_cast(float, __builtin_amdgcn_readlane(iv, 32)), __builtin_bit_cast(float, __builtin_amdgcn_readlane(iv, 48))));
}
__device__ __forceinline__ float dpp_xor1(float v) { return __builtin_bit_cast(float, __builtin_amdgcn_update_dpp(0, __builtin_bit_cast(int, v), 0xB1, 0xF, 0xF, true)); }
__device__ __forceinline__ float dpp_xor2(float v) { return __builtin_bit_cast(float, __builtin_amdgcn_update_dpp(0, __builtin_bit_cast(int, v), 0x4E, 0xF, 0xF, true)); }
__device__ __forceinline__ float dpp_hmirror(float v) { return __builtin_bit_cast(float, __builtin_amdgcn_update_dpp(0, __builtin_bit_cast(int, v), 0x141, 0xF, 0xF, true)); }
__device__ __forceinline__ float vsel(bool c, float a, float b) { asm volatile("" : "+v"(a), "+v"(b)); return c ? a : b; }
__device__ __forceinline__ float xor32(float v, int hi) { auto rr = __builtin_amdgcn_permlane32_swap(__float_as_uint(v), __float_as_uint(v), false, false); return __uint_as_float(hi ? rr[0] : rr[1]); }

__device__ __forceinline__ void transpose_item(const float* W, int K, int N, bf16* dst0, int k0, int n0, LAS float* scr, int lane, const float* gk) {
    f32x4 v[8];
#pragma unroll
    for (int i = 0; i < 8; ++i) { const int kk = 8 * i + (lane >> 3); v[i] = __builtin_nontemporal_load((const f32x4*)(W + (size_t)(k0 + kk) * N + n0 + 4 * (lane & 7))); }
#pragma unroll
    for (int i = 0; i < 8; ++i) { const int kk = 8 * i + (lane >> 3); const float g = gk ? gk[k0 + kk] : 1.0f; LAS float* s = scr + kk * 33 + 4 * (lane & 7);
        s[0] = v[i].x * g; s[1] = v[i].y * g; s[2] = v[i].z * g; s[3] = v[i].w * g; }
    LDS_WAIT(); asm volatile("" ::: "memory");
    const int c = lane & 7;
#pragma unroll
    for (int j = 0; j < 4; ++j) { const int n = (lane >> 3) + 8 * j; const LAS float* s = scr + (8 * c) * 33 + n;
        v4u o; o.x = pk2(s[0 * 33], s[1 * 33]); o.y = pk2(s[2 * 33], s[3 * 33]); o.z = pk2(s[4 * 33], s[5 * 33]); o.w = pk2(s[6 * 33], s[7 * 33]);
        *(v4u*)(dst0 + (size_t)n * K + k0 + 8 * c) = o; }
    LDS_WAIT(); asm volatile("" ::: "memory");
}
__device__ __forceinline__ void conv_item(const float* W, int K, int N, bf16* WT, int mode, int item, LAS float* scr, int lane, const float* gk = nullptr) {
    const int nblk = N / 32, kb = item / nblk, nb = item % nblk, k0 = 64 * kb, n0 = 32 * nb;
    const int drow = mode == 0 ? n0 : (256 * (n0 >> 7) + (n0 & 127) + (mode == 2 ? 128 : 0));
    transpose_item(W, K, N, WT + (size_t)drow * K, k0, n0, scr, lane, gk);
}

__device__ __forceinline__ float sumsq8(const f32x4 (&x)[8]) { float ss = 0.f;
#pragma unroll
    for (int j = 0; j < 8; ++j) ss += (x[j].x * x[j].x + x[j].y * x[j].y) + (x[j].z * x[j].z + x[j].w * x[j].w);
    return ss; }
__device__ __forceinline__ void load_bf_row(const bf16* p, int lane, f32x4 (&x)[8]) { const v2u* r = (const v2u*)p + lane; v2u b[8];
#pragma unroll
    for (int j = 0; j < 8; ++j) b[j] = r[64 * j];
#pragma unroll
    for (int j = 0; j < 8; ++j) x[j] = (f32x4){bflo(b[j].x), bfhi(b[j].x), bflo(b[j].y), bfhi(b[j].y)}; }
__device__ __forceinline__ void store_xb_rs(const f32x4 (&x)[8], bf16* XBrow, float* RSrow, int lane) {
    const float r = __builtin_amdgcn_rsqf(wave_sum(sumsq8(x)) * (1.0f / DM) + EPS);
    v2u* o = (v2u*)XBrow + lane;
#pragma unroll
    for (int j = 0; j < 8; ++j) { v2u w; w.x = pk2(x[j].x, x[j].y); w.y = pk2(x[j].z, x[j].w); o[64 * j] = w; }
    if (lane == 0) *RSrow = r;
}
__device__ __forceinline__ void pre_rows(const Frame& F, const float* xin, bf16* XB, float* RS, int nrows) {
    int row = F.gw; f32x4 cur[8], nxt[8];
    if (row < nrows) { const f32x4* xr = (const f32x4*)(xin + (size_t)row * DM) + F.lane;
#pragma unroll
        for (int j = 0; j < 8; ++j) cur[j] = __builtin_nontemporal_load(xr + 64 * j); }
    while (row < nrows) {
        const int nrow = row + F.NGW;
        { const f32x4* xr = (const f32x4*)(xin + (size_t)(nrow < nrows ? nrow : row) * DM) + F.lane;
#pragma unroll
            for (int j = 0; j < 8; ++j) nxt[j] = __builtin_nontemporal_load(xr + 64 * j); }
        store_xb_rs(cur, XB + (size_t)row * DM, RS + row, F.lane);
#pragma unroll
        for (int j = 0; j < 8; ++j) cur[j] = nxt[j];
        row = nrow;
    }
}
template <bool XIN_F32, bool NEXT> struct RowRaw { f32x4 x32[XIN_F32 ? 8 : 1]; v2u xb[XIN_F32 ? 1 : 8]; v2u y[8]; f32x4 n32[NEXT ? 8 : 1]; };
template <bool XIN_F32, bool NEXT>
__device__ __forceinline__ void row_load(RowRaw<XIN_F32, NEXT>& R, const float* xin32, const bf16* XB, const bf16* Y, const float* xnext, int row, int lane) {
    if (XIN_F32) { const f32x4* xr = (const f32x4*)(xin32 + (size_t)row * DM) + lane;
#pragma unroll
        for (int j = 0; j < 8; ++j) R.x32[j] = xr[64 * j]; }
    else { const v2u* xr = (const v2u*)(XB + (size_t)row * DM) + lane;
#pragma unroll
        for (int j = 0; j < 8; ++j) R.xb[j] = xr[64 * j]; }
    { const v2u* yr = (const v2u*)(Y + (size_t)row * DM) + lane;
#pragma unroll
        for (int j = 0; j < 8; ++j) R.y[j] = __builtin_nontemporal_load(yr + 64 * j); }
    if (NEXT) { const f32x4* xr = (const f32x4*)(xnext + (size_t)row * DM) + lane;
#pragma unroll
        for (int j = 0; j < 8; ++j) R.n32[j] = __builtin_nontemporal_load(xr + 64 * j); }
}
template <bool XIN_F32, bool FINAL, bool NEXT>
__device__ __forceinline__ void t_rows(const Frame& F, const float* xin32, const bf16* Y, float coef, const float* gpost, float* out32, bf16* XB, float* RS, const float* xnext, int nrows) {
    f32x4 gp[8];
#pragma unroll
    for (int j = 0; j < 8; ++j) gp[j] = ((const f32x4*)gpost)[64 * j + F.lane];
    int row = F.gw; RowRaw<XIN_F32, NEXT> cur, nxt;
    if (row < nrows) row_load<XIN_F32, NEXT>(cur, xin32, XB, Y, xnext, row, F.lane);
    while (row < nrows) {
        const int nrow = row + F.NGW;
        row_load<XIN_F32, NEXT>(nxt, xin32, XB, Y, xnext, nrow < nrows ? nrow : row, F.lane);
        f32x4 x[8], y[8];
#pragma unroll
        for (int j = 0; j < 8; ++j) { x[j] = XIN_F32 ? cur.x32[j] : (f32x4){bflo(cur.xb[j].x), bfhi(cur.xb[j].x), bflo(cur.xb[j].y), bfhi(cur.xb[j].y)};
            y[j] = (f32x4){bflo(cur.y[j].x), bfhi(cur.y[j].x), bflo(cur.y[j].y), bfhi(cur.y[j].y)}; }
        const float r = coef * __builtin_amdgcn_rsqf(wave_sum(sumsq8(y)) * (1.0f / DM) + EPS);
#pragma unroll
        for (int j = 0; j < 8; ++j) x[j] = x[j] + (y[j] * gp[j]) * r;
        if (FINAL) { f32x4* xo = (f32x4*)(out32 + (size_t)row * DM) + F.lane;
#pragma unroll
            for (int j = 0; j < 8; ++j) __builtin_nontemporal_store(x[j], xo + 64 * j);
            if (NEXT) { f32x4 xn[8];
#pragma unroll
                for (int j = 0; j < 8; ++j) xn[j] = cur.n32[j];
                store_xb_rs(xn, XB + (size_t)row * DM, RS + row, F.lane); } }
        else store_xb_rs(x, XB + (size_t)row * DM, RS + row, F.lane);
        cur = nxt; row = nrow;
    }
}
__device__ __forceinline__ void unpack8(const v4u w, float (&f)[8]) { f[0] = bflo(w.x); f[1] = bfhi(w.x); f[2] = bflo(w.y); f[3] = bfhi(w.y); f[4] = bflo(w.z); f[5] = bfhi(w.z); f[6] = bflo(w.w); f[7] = bfhi(w.w); }
__device__ __forceinline__ float gelu_tanh(float x) { const float z = 1.5957691216057308f * (x + 0.044715f * x * x * x); return x * __builtin_amdgcn_rcpf(1.0f + __builtin_amdgcn_exp2f(-1.4426950408889634f * z)); }
struct MixRaw { v4u o[2], y[2], hf[2], pf[2], hb[2], pb[2]; };
__device__ __forceinline__ void mix_load(MixRaw& R, const bf16* Z, const bf16* HLF, const bf16* PRF, const bf16* HLB, const bf16* PRB, int row, int lane) {
    const bf16* zr = Z + (size_t)row * INW; const size_t ro = (size_t)row * RNNW;
#pragma unroll
    for (int j = 0; j < 2; ++j) { const int c = 512 * j + 8 * lane; R.o[j] = __builtin_nontemporal_load((const v4u*)(zr + ZQ + c)); R.y[j] = __builtin_nontemporal_load((const v4u*)(zr + ZYR + c));
        R.hf[j] = __builtin_nontemporal_load((const v4u*)(HLF + ro + c)); R.pf[j] = __builtin_nontemporal_load((const v4u*)(PRF + ro + c)); R.hb[j] = __builtin_nontemporal_load((const v4u*)(HLB + ro + c)); R.pb[j] = __builtin_nontemporal_load((const v4u*)(PRB + ro + c)); }
}
__device__ __forceinline__ void mix_rows(const Frame& F, const bf16* Z, const bf16* HLF, const bf16* PRF, const bf16* HLB, const bf16* PRB, const float* CIN, const float* ga, const float* gr, bf16* MIX) {
    f32x4 gA[2][2], gR[2][2];
#pragma unroll
    for (int j = 0; j < 2; ++j)
#pragma unroll
        for (int q = 0; q < 2; ++q) { gA[j][q] = *(const f32x4*)(ga + 512 * j + 8 * F.lane + 4 * q); gR[j][q] = *(const f32x4*)(gr + 512 * j + 8 * F.lane + 4 * q); }
    int row = F.gw; MixRaw cur, nxt;
    if (row < MH) mix_load(cur, Z, HLF, PRF, HLB, PRB, row, F.lane);
    while (row < MH) {
        const int nrow = row + F.NGW;
        mix_load(nxt, Z, HLF, PRF, HLB, PRB, nrow < MH ? nrow : row, F.lane);
        const float* cf = CIN + (size_t)(row / LC) * 2 * RNNW; const float* cb = cf + RNNW;
        float o[2][8], rn[2][8]; float sa = 0.f, sr = 0.f;
#pragma unroll
        for (int j = 0; j < 2; ++j) { float y[8], hf[8], pf[8], hb[8], pb[8]; unpack8(cur.o[j], o[j]); unpack8(cur.y[j], y); unpack8(cur.hf[j], hf); unpack8(cur.pf[j], pf); unpack8(cur.hb[j], hb); unpack8(cur.pb[j], pb);
            const int c = 512 * j + 8 * F.lane; const f32x4 f0 = *(const f32x4*)(cf + c), f1 = *(const f32x4*)(cf + c + 4), b0 = *(const f32x4*)(cb + c), b1 = *(const f32x4*)(cb + c + 4);
            const float cfv[8] = {f0.x, f0.y, f0.z, f0.w, f1.x, f1.y, f1.z, f1.w}, cbv[8] = {b0.x, b0.y, b0.z, b0.w, b1.x, b1.y, b1.z, b1.w};
#pragma unroll
            for (int e = 0; e < 8; ++e) { sa += o[j][e] * o[j][e]; const float h = (hf[e] + pf[e] * cfv[e]) + (hb[e] + pb[e] * cbv[e]); rn[j][e] = h * gelu_tanh(y[e]); sr += rn[j][e] * rn[j][e]; } }
        const float ra = __builtin_amdgcn_rsqf(wave_sum(sa) * (1.0f / ATTW) + EPS), rr = __builtin_amdgcn_rsqf(wave_sum(sr) * (1.0f / RNNW) + EPS);
        bf16* mo = MIX + (size_t)row * DM;
#pragma unroll
        for (int j = 0; j < 2; ++j) {
            v4u w; w.x = pk2(o[j][0] * ra * gA[j][0].x, o[j][1] * ra * gA[j][0].y); w.y = pk2(o[j][2] * ra * gA[j][0].z, o[j][3] * ra * gA[j][0].w);
            w.z = pk2(o[j][4] * ra * gA[j][1].x, o[j][5] * ra * gA[j][1].y); w.w = pk2(o[j][6] * ra * gA[j][1].z, o[j][7] * ra * gA[j][1].w);
            *(v4u*)(mo + 512 * j + 8 * F.lane) = w;
            v4u v; v.x = pk2(rn[j][0] * rr * gR[j][0].x, rn[j][1] * rr * gR[j][0].y); v.y = pk2(rn[j][2] * rr * gR[j][0].z, rn[j][3] * rr * gR[j][0].w);
            v.z = pk2(rn[j][4] * rr * gR[j][1].x, rn[j][5] * rr * gR[j][1].y); v.w = pk2(rn[j][6] * rr * gR[j][1].z, rn[j][7] * rr * gR[j][1].w);
            *(v4u*)(mo + ATTW + 512 * j + 8 * F.lane) = v;
        }
        cur = nxt; row = nrow;
    }
}

__device__ __forceinline__ void rope_table(const Frame& F, float* tab) {
    const int gid = F.bid * (NWAVES * 64) + F.tid;
    if (gid < 256 * 32) {
        const int pos = gid >> 5, p = gid & 31;
        double f = 1.0; for (int i = 0; i < p; ++i) f *= 0.7498942093324558;
        const float inv = (float)f; const float ang = (float)pos * inv;
        const double a = (double)ang; const double kq = __builtin_rint(a * 0.6366197723675814); const double r = a - kq * 1.5707963267948966, r2 = r * r;
        const double s = r * (1.0 + r2 * (-1.0 / 6 + r2 * (1.0 / 120 + r2 * (-1.0 / 5040 + r2 * (1.0 / 362880 + r2 * (-1.0 / 39916800 + r2 * (1.0 / 6227020800.0)))))));
        const double c = 1.0 + r2 * (-0.5 + r2 * (1.0 / 24 + r2 * (-1.0 / 720 + r2 * (1.0 / 40320 + r2 * (-1.0 / 3628800 + r2 * (1.0 / 479001600.0))))));
        const int q = ((int)kq) & 3;
        const double cs = q == 0 ? c : (q == 1 ? -s : (q == 2 ? -c : s)), sn = q == 0 ? s : (q == 1 ? c : (q == 2 ? -s : -c));
        tab[2 * gid] = (float)cs; tab[2 * gid + 1] = (float)sn;
    }
}
__device__ __forceinline__ float attn_bound(const float* gqp, const float* gkp, int lane) {
    float mq = fmaxf(fabsf(gqp[lane]), fabsf(gqp[lane + 64])), mk = fmaxf(fabsf(gkp[lane]), fabsf(gkp[lane + 64]));
    mq = wave_max(mq); mk = wave_max(mk);
    return __builtin_bit_cast(float, __builtin_amdgcn_readfirstlane(__builtin_bit_cast(int, 128.0f * mq * mk * att::SCALE)));
}
constexpr float ATT_FIX_MAX = 30.0f;
__device__ __forceinline__ bf16* rope_ptr(bf16* Z, int job, int lane) {
    const int i8 = lane & 7; const bool isq = job < MH;
    const int row = isq ? job : 4 * (job - MH) + (lane >> 4);
    const int col = isq ? (ZQ + (lane >> 3) * 128 + i8 * 16) : (ZK + ((lane >> 3) & 1) * 128 + i8 * 16);
    return Z + (size_t)row * INW + col;
}
__device__ __forceinline__ void rope_rows(const Frame& F, bf16* Z, const float* gqp, const float* gkp, const float* tab, int S) {
    const int i8 = F.lane & 7;
    const float qmul = attn_bound(gqp, gkp, F.lane) <= ATT_FIX_MAX ? att::SCALE * 1.4426950408889634f : 1.0f;
    float gq[16], gk[16];
#pragma unroll
    for (int e = 0; e < 16; ++e) { gq[e] = gqp[16 * i8 + e]; gk[e] = gkp[16 * i8 + e]; }
    const int axis = i8 >> 2, hsel = (i8 >> 1) & 1, p0 = 16 * (i8 & 1);
    constexpr int NJ = MH + MH / 4;
    int job = (qmul != 1.0f ? MH : 0) + F.gw; if (job >= NJ) return;
    v4u w0, w1; { const bf16* p = rope_ptr(Z, job, F.lane); w0 = *(const v4u*)p; w1 = *(const v4u*)(p + 8); }
    while (job < NJ) {
        const int njob = job + F.NGW; v4u n0, n1;
        { const bf16* p = rope_ptr(Z, njob < NJ ? njob : job, F.lane); n0 = *(const v4u*)p; n1 = *(const v4u*)(p + 8); }
        const bool isq = job < MH;
        const int row = isq ? job : 4 * (job - MH) + (F.lane >> 4);
        bf16* p = rope_ptr(Z, job, F.lane);
        float x[16]; { float a[8], b[8]; unpack8(w0, a); unpack8(w1, b);
#pragma unroll
            for (int e = 0; e < 8; ++e) { x[e] = a[e]; x[8 + e] = b[e]; } }
        float ss = 0.f;
#pragma unroll
        for (int e = 0; e < 16; ++e) ss += x[e] * x[e];
        ss += dpp_xor1(ss); ss += dpp_xor2(ss); ss += dpp_hmirror(ss);
        const float rs = __builtin_amdgcn_rsqf(ss * (1.0f / 128) + EPS);
        const int t = row % S; const int pos = axis ? (t & 63) : (t >> 6);
        const f32x4* tp = (const f32x4*)(tab + (size_t)(pos * 32 + p0) * 2);
        float out[16];
#pragma unroll
        for (int e2 = 0; e2 < 8; ++e2) {
            const f32x4 cs = tp[e2];
#pragma unroll
            for (int q = 0; q < 2; ++q) { const int e = 2 * e2 + q; const float xn = x[e] * rs * (isq ? gq[e] * qmul : gk[e]); const float pr = dpp_xor2(xn);
                const float c = q ? cs.z : cs.x, s = q ? cs.w : cs.y; out[e] = hsel ? (xn * c + pr * s) : (xn * c - pr * s); }
        }
        v4u o0, o1; o0.x = pk2(out[0], out[1]); o0.y = pk2(out[2], out[3]); o0.z = pk2(out[4], out[5]); o0.w = pk2(out[6], out[7]);
        o1.x = pk2(out[8], out[9]); o1.y = pk2(out[10], out[11]); o1.z = pk2(out[12], out[13]); o1.w = pk2(out[14], out[15]);
        *(v4u*)p = o0; *(v4u*)(p + 8) = o1;
        w0 = n0; w1 = n1; job = njob;
    }
}

template <int DIR>
__device__ __forceinline__ void rnn_tile_scan(float (&a)[16], float (&u)[16], int hi, float& carry, float& aprod) {
    const int he = DIR ? 1 - hi : hi;
    float Ag[4], Bg[4];
#pragma unroll
    for (int g = 0; g < 4; ++g) { float P = 1.f, H = 0.f;
#pragma unroll
        for (int j = 0; j < 4; ++j) { const int r = DIR ? 15 - (4 * g + j) : 4 * g + j; H = a[r] * H + u[r]; P = P * a[r]; u[r] = H; a[r] = P; }
        Ag[g] = P; Bg[g] = H; }
    float c = carry, ap = aprod;
#pragma unroll
    for (int g = 0; g < 4; ++g) {
        const auto sA = __builtin_amdgcn_permlane32_swap(__float_as_uint(Ag[g]), __float_as_uint(Ag[g]), false, false); const auto sB = __builtin_amdgcn_permlane32_swap(__float_as_uint(Bg[g]), __float_as_uint(Bg[g]), false, false);
        const float A0 = __uint_as_float(sA[DIR]), B0 = __uint_as_float(sB[DIR]), A1 = __uint_as_float(sA[1 - DIR]), B1 = __uint_as_float(sB[1 - DIR]);
        const float c0 = c; c = A0 * c + B0; const float c1 = c; c = A1 * c + B1;
        const float ap0 = ap, ap1 = ap * A0; ap = ap1 * A1;
        const float cown = he ? c1 : c0, apown = he ? ap1 : ap0;
#pragma unroll
        for (int j = 0; j < 4; ++j) { const int r = DIR ? 15 - (4 * g + j) : 4 * g + j; u[r] = u[r] + a[r] * cown; a[r] = a[r] * apown; }
    }
    carry = c; aprod = ap;
}
__device__ __forceinline__ void rnn_store_tile(const float (&x)[16], bf16* base  , int hi, int odd) {
#pragma unroll
    for (int i = 0; i < 8; ++i) { const int r0 = 2 * i, r1 = 2 * i + 1;
        const float recv = dpp_xor1(vsel(odd, x[r0], x[r1]));
        const unsigned w = pk2(vsel(odd, recv, x[r0]), vsel(odd, x[r1], recv));
        const int row = odd ? ((r1 & 3) + 8 * (r1 >> 2) + 4 * hi) : ((r0 & 3) + 8 * (r0 >> 2) + 4 * hi);
        *(unsigned*)(base + (size_t)row * RNNW) = w; }
}
__device__ __forceinline__ void rnn_pass(const Frame& F, ArgP A, int S) {
    LAS unsigned char* img = F.lds + RING_OFF;
    const int dir = F.wave >> 2, cq = F.wave & 3, n = F.lane & 31, hi = F.lane >> 5;
    const bf16* Z = wsp<bf16>(A, WS_Z);
    int cur_blk = -1;
    bf16x8 Wa[8], Wx[8]; float ba = 0.f, bx = 0.f, cneg = 0.f;
    for (int unit = F.bid; unit < NCHUNK * 8; unit += F.G) {
        const int blk = unit & 7, chunk = unit >> 3, zr0 = chunk * LC;
        const int ch = blk * 128 + cq * 32 + n;
        if (blk != cur_blk) {
            cur_blk = blk;
            const float* wa = inp(A, dir ? 18 : 13) + ((size_t)blk * 128 + 8 * hi) * 128 + cq * 32 + n; const float* wx = inp(A, dir ? 20 : 15) + ((size_t)blk * 128 + 8 * hi) * 128 + cq * 32 + n;
#pragma unroll
            for (int ks = 0; ks < 8; ++ks) { float va[8], vx[8];
#pragma unroll
                for (int j = 0; j < 8; ++j) { va[j] = wa[(16 * ks + j) * 128]; vx[j] = wx[(16 * ks + j) * 128]; }
                v4u pa, px; pa.x = pk2(va[0], va[1]); pa.y = pk2(va[2], va[3]); pa.z = pk2(va[4], va[5]); pa.w = pk2(va[6], va[7]);
                px.x = pk2(vx[0], vx[1]); px.y = pk2(vx[2], vx[3]); px.z = pk2(vx[4], vx[5]); px.w = pk2(vx[6], vx[7]);
                Wa[ks] = __builtin_bit_cast(bf16x8, pa); Wx[ks] = __builtin_bit_cast(bf16x8, px); }
            ba = -1.4426950408889634f * inp(A, dir ? 19 : 14)[ch]; bx = -1.4426950408889634f * inp(A, dir ? 21 : 16)[ch];
            cneg = -8.0f * 1.4426950408889634f * log1pf(expf(-inp(A, dir ? 22 : 17)[ch]));
        }
        __syncthreads();
        {
            const int ch4 = (F.tid & 31) * 4;
            const int sq0 = (zr0 / S) * S, sq1 = sq0 + S;
            const float* wcv = inp(A, 11) + blk * 128 + ch4; const f32x4 bc = *(const f32x4*)(inp(A, 12) + blk * 128 + ch4);
            const f32x4 w0 = *(const f32x4*)(wcv), w1 = *(const f32x4*)(wcv + RNNW), w2 = *(const f32x4*)(wcv + 2 * RNNW), w3 = *(const f32x4*)(wcv + 3 * RNNW);
            for (int hh = 0; hh < 2; ++hh) {
                const int r0 = ((F.tid >> 5) + 16 * hh) * 8;
                v2u xin[11];
#pragma unroll
                for (int i = 0; i < 11; ++i) { const int row = zr0 + r0 - 2 + i; const bool ok = row >= sq0 && row < sq1;
                    xin[i] = ok ? __builtin_nontemporal_load((const v2u*)(Z + (size_t)row * INW + ZXR + blk * 128 + ch4)) : (v2u){0u, 0u}; }
#pragma unroll
                for (int rr = 0; rr < 8; ++rr) {
                    const f32x4 x0 = (f32x4){bflo(xin[rr].x), bfhi(xin[rr].x), bflo(xin[rr].y), bfhi(xin[rr].y)}, x1 = (f32x4){bflo(xin[rr + 1].x), bfhi(xin[rr + 1].x), bflo(xin[rr + 1].y), bfhi(xin[rr + 1].y)};
                    const f32x4 x2 = (f32x4){bflo(xin[rr + 2].x), bfhi(xin[rr + 2].x), bflo(xin[rr + 2].y), bfhi(xin[rr + 2].y)}, x3 = (f32x4){bflo(xin[rr + 3].x), bfhi(xin[rr + 3].x), bflo(xin[rr + 3].y), bfhi(xin[rr + 3].y)};
                    const f32x4 xc = bc + ((w0 * x0 + w1 * x1) + (w2 * x2 + w3 * x3));
                    v2u o; o.x = pk2(xc.x, xc.y); o.y = pk2(xc.z, xc.w);
                    const int row = r0 + rr; *(LAS v2u*)(img + row * 256 + ((ch4 * 2) ^ ((row & 7) << 4))) = o; }
            }
        }
        __syncthreads();
        float carry = 0.f, aprod = 1.f;
        bf16* HLo = wsp<bf16>(A, dir ? WS_HLB : WS_HLF) + (size_t)zr0 * RNNW + (ch & ~1); bf16* PRo = wsp<bf16>(A, dir ? WS_PRB : WS_PRF) + (size_t)zr0 * RNNW + (ch & ~1);
        for (int it = 0; it < 8; ++it) {
            const int rt = dir ? 7 - it : it;
            f32x16 ca = {}, cx = {};
#pragma unroll
            for (int ks = 0; ks < 8; ++ks) { const int row = 32 * rt + n; const bf16x8 Af = *(const LAS bf16x8*)(img + row * 256 + ((32 * ks + 16 * hi) ^ ((row & 7) << 4)));
                ca = __builtin_amdgcn_mfma_f32_32x32x16_bf16(Af, Wa[ks], ca, 0, 0, 0); cx = __builtin_amdgcn_mfma_f32_32x32x16_bf16(Af, Wx[ks], cx, 0, 0, 0); }
            float a[16], u[16];
#pragma unroll
            for (int r = 0; r < 16; ++r) { const int row = 32 * rt + (r & 3) + 8 * (r >> 2) + 4 * hi;
                const float xcv = __uint_as_float((unsigned)(*(const LAS unsigned short*)(img + row * 256 + (((cq * 32 + n) * 2) ^ ((row & 7) << 4)))) << 16);
                const float rg_ = __builtin_amdgcn_rcpf(1.0f + __builtin_amdgcn_exp2f(fmaf(ca[r], -1.4426950408889634f, ba)));
                const float ig = __builtin_amdgcn_rcpf(1.0f + __builtin_amdgcn_exp2f(fmaf(cx[r], -1.4426950408889634f, bx)));
                const float av = __builtin_amdgcn_exp2f(cneg * rg_);
                a[r] = av; u[r] = __builtin_amdgcn_sqrtf(fmaxf(fmaf(-av, av, 1.0f), 0.f)) * (ig * xcv); }
            if (dir == 0) rnn_tile_scan<0>(a, u, hi, carry, aprod); else rnn_tile_scan<1>(a, u, hi, carry, aprod);
            rnn_store_tile(u, HLo + (size_t)(32 * rt) * RNNW, hi, n & 1);
            rnn_store_tile(a, PRo + (size_t)(32 * rt) * RNNW, hi, n & 1);
        }
        if (hi == 0) wsp<f32x2>(A, WS_SUM)[((size_t)chunk * 2 + dir) * RNNW + ch] = (f32x2){aprod, carry};
    }
}
__device__ __forceinline__ void rnn_carry(const Frame& F, const f32x2* SUM, float* CIN, int nseq, int cps) {
    const int gid = F.bid * (NWAVES * 64) + F.tid;
    if (gid >= nseq * 2 * RNNW) return;
    const int s = gid / (2 * RNNW), rem = gid % (2 * RNNW), dir = rem / RNNW, ch = rem % RNNW;
    float st = 0.f;
#pragma unroll 8
    for (int i = 0; i < cps; ++i) { const int c = s * cps + (dir ? cps - 1 - i : i); const size_t o = ((size_t)c * 2 + dir) * RNNW + ch;
        CIN[o] = st; const f32x2 ab = SUM[o]; st = ab.x * st + ab.y; }
}

constexpr int PH_PER_HALF = 12, N_PHASES = 1 + 2 * PH_PER_HALF;
#define IN(k) (LO <= (k) && (k) < HI)
#define SEAM(k) do { if constexpr (LO <= (k) && (k) + 1 < HI) xcd_barrier(bar); } while (0)
#ifndef GEMM_ALIGN
#define GEMM_ALIGN true
#endif
#ifndef GEMM_SP2
#define GEMM_SP2 true
#endif
#define GEMM_SITE(EPI, Aoff, Boff, N_, K_, Ooff, ldo, RSP) do { Frame F = mkframe(lds, bar.wv); ArgP A = argp(); \
        pg8::Gemm g{wsp<bf16>(A, Aoff), wsp<bf16>(A, Boff), MH, N_, K_}; pg8::StaticOrder So; So.init(MH, N_, F.G, F.bid); \
        EPI E{wsp<bf16>(A, Ooff), ldo, RSP}; pg8::gemm_phase<EPI, pg8::StaticOrder, GEMM_ALIGN, GEMM_SP2>(F.lds + RING_OFF, g, So, E, F.tid); } while (0)

template <int H, int LO, int HI>
__device__ __forceinline__ void trunk(unsigned char* lds, const XcdBarrier& bar) {
    constexpr int pb = 1 + H * PH_PER_HALF;
    constexpr int S = H ? 16384 : 4096;
    constexpr size_t xoff = (size_t)H * MH * DM;
    if constexpr (IN(pb + 0)) GEMM_SITE(pg8::EpiSwiglu, WS_XN, WS_WGU1, NGU, DM, WS_H, DFF, wsp<float>(A, WS_RS));
    SEAM(pb + 0);
    if constexpr (IN(pb + 1)) GEMM_SITE(pg8::EpiBf16, WS_H, WS_WD1, DM, DFF, WS_Y, DM, nullptr);
    SEAM(pb + 1);
    if constexpr (IN(pb + 2)) { Frame F = mkframe(lds, bar.wv); ArgP A = argp();
        t_rows<false, false, false>(F, nullptr, wsp<bf16>(A, WS_Y), 0.5f, inp(A, 6), nullptr, wsp<bf16>(A, WS_XN), wsp<float>(A, WS_RS), nullptr, MH); }
    SEAM(pb + 2);
    if constexpr (IN(pb + 3)) GEMM_SITE(pg8::EpiBf16, WS_XN, WS_WIN, INW, DM, WS_Z, INW, wsp<float>(A, WS_RS));
    SEAM(pb + 3);
    if constexpr (IN(pb + 4)) {
        { Frame F = mkframe(lds, bar.wv); ArgP A = argp(); rope_rows(F, wsp<bf16>(A, WS_Z), inp(A, 9), inp(A, 10), wsp<float>(A, WS_ROPE), S); }
        { Frame F = mkframe(lds, bar.wv); ArgP A = argp(); rnn_pass(F, A, S); }
        __syncthreads();
    }
    SEAM(pb + 4);
    if constexpr (IN(pb + 5)) {
        { Frame F = mkframe(lds, bar.wv); ArgP A = argp(); rnn_carry(F, wsp<f32x2>(A, WS_SUM), wsp<float>(A, WS_CIN), MH / S, S / LC); }
        Frame F = mkframe(lds, bar.wv); ArgP A = argp();
        const bf16* Zb = wsp<bf16>(A, WS_Z);
        const float mfix = attn_bound(inp(A, 9), inp(A, 10), F.lane); const bool fixm = mfix <= ATT_FIX_MAX;
#define ATT_LOOP(FIX) do { Frame F2 = mkframe<(FIX) ? 1 : 2>(lds, bar.wv); ArgP A2 = argp(); const bf16* Zb2 = wsp<bf16>(A2, WS_Z); const int x = F2.bid & 7, rk = F2.bid >> 3; constexpr int nqb = S / 256, UG = 4 * nqb; \
        for (int idx = F2.bid; idx < 1024; idx += F2.G) { int id = idx; if (F2.G == 256) { const int t = (idx - F2.bid) / 256; id = x * 128 + t * 32 + rk; }     \
            const int grp = id / UG, uu = id % UG, b = grp >> 1, kvh = grp & 1, head = kvh * 4 + uu / nqb, qb = uu % nqb; \
            const bf16* zb = Zb2 + (size_t)b * S * INW; bf16* qp = (bf16*)zb + (size_t)qb * 256 * INW + ZQ + head * 128; \
            if constexpr ((FIX) && ATT_MFMA16) att::attn_unit16<S / 64>(qp, zb + ZK + kvh * 128, zb + ZV + kvh * 128, qp, (char*)lds + RING_OFF, F2.lds + RING_OFF, F2.tid, inp(A2, 9), wsp<float>(A2, WS_ROPE), qb * 256, att::SCALE * 1.4426950408889634f); \
            else att::attn_unit<FIX, S / 64>(qp, zb + ZK + kvh * 128, zb + ZV + kvh * 128, qp, S, (char*)lds + RING_OFF, F2.lds + RING_OFF, F2.tid, mfix, inp(A2, 9), wsp<float>(A2, WS_ROPE), qb * 256, (FIX) ? att::SCALE * 1.4426950408889634f : 1.0f); } } while (0)
        if (fixm) ATT_LOOP(true); else ATT_LOOP(false);
#undef ATT_LOOP
    }
    SEAM(pb + 5);
    if constexpr (IN(pb + 6)) { Frame F = mkframe(lds, bar.wv); ArgP A = argp();
        mix_rows(F, wsp<bf16>(A, WS_Z), wsp<bf16>(A, WS_HLF), wsp<bf16>(A, WS_PRF), wsp<bf16>(A, WS_HLB), wsp<bf16>(A, WS_PRB), wsp<float>(A, WS_CIN), inp(A, 23), inp(A, 24), wsp<bf16>(A, WS_MIX)); }
    SEAM(pb + 6);
    if constexpr (IN(pb + 7)) GEMM_SITE(pg8::EpiBf16, WS_MIX, WS_WOUT, DM, DM, WS_Y, DM, nullptr);
    SEAM(pb + 7);
    if constexpr (IN(pb + 8)) { Frame F = mkframe(lds, bar.wv); ArgP A = argp();
        t_rows<false, false, false>(F, nullptr, wsp<bf16>(A, WS_Y), 1.0f, inp(A, 26), nullptr, wsp<bf16>(A, WS_XN), wsp<float>(A, WS_RS), nullptr, MH); }
    SEAM(pb + 8);
    if constexpr (IN(pb + 9)) GEMM_SITE(pg8::EpiSwiglu, WS_XN, WS_WGU2, NGU, DM, WS_H, DFF, wsp<float>(A, WS_RS));
    SEAM(pb + 9);
    if constexpr (IN(pb + 10)) GEMM_SITE(pg8::EpiBf16, WS_H, WS_WD2, DM, DFF, WS_Y, DM, nullptr);
    SEAM(pb + 10);
    if constexpr (IN(pb + 11)) { Frame F = mkframe(lds, bar.wv); ArgP A = argp();
        t_rows<false, true, H == 0>(F, nullptr, wsp<bf16>(A, WS_Y), 0.5f, inp(A, 31), outp(A) + xoff, wsp<bf16>(A, WS_XN), wsp<float>(A, WS_RS), H == 0 ? inp(A, 1) : nullptr, MH); }
    if constexpr (H == 0) SEAM(pb + 11);
}

template <int LO, int HI>
__global__ void __launch_bounds__(NWAVES * 64, 2) hymba_fwd(Args args_unused) {
    extern __shared__ __attribute__((aligned(16))) unsigned char lds[];
    {   LAS unsigned char* l = (LAS unsigned char*)lds;
        for (int u = threadIdx.x; u < (LDS_BYTES - LDSCTL_OFF) / 4; u += NWAVES * 64) ((LAS unsigned*)(l + LDSCTL_OFF))[u] = 0u; }
    __syncthreads();
    int wv0 = __builtin_amdgcn_readfirstlane((int)threadIdx.x >> 6); asm volatile("" : "+s"(wv0));
    XcdBarrier bar; bar.bar = nullptr; bar.x = 0; bar.st = nullptr; bar.wv = wv0;
    if constexpr (HI - LO > 1) { ArgP A = argp(); bar = xcd_barrier_post(wsp<unsigned>(A, WS_CTL) + CW_BAR, (volatile LAS unsigned*)((LAS unsigned char*)lds + MISC_OFF) + 8, wv0); }

    if constexpr (IN(0)) {
        Frame F = mkframe(lds, bar.wv); ArgP A = argp();
        LAS float* scr = (LAS float*)(F.lds + RING_OFF + F.wave * 16384);
        constexpr int I_GU = (DM / 64) * (DFF / 32), I_D = (DFF / 64) * (DM / 32), I_IN = (DM / 64) * (INW / 32), I_O = (DM / 64) * (DM / 32);
        constexpr int NITEMS = 4 * I_GU + 2 * I_D + I_IN + I_O;
        for (int it = F.gw; it < NITEMS; it += F.NGW) {
            int r = it;
            if (r < I_GU) { conv_item(inp(A, 3), DM, DFF, wsp<bf16>(A, WS_WGU1), 1, r, scr, F.lane, inp(A, 2)); continue; } r -= I_GU;
            if (r < I_GU) { conv_item(inp(A, 4), DM, DFF, wsp<bf16>(A, WS_WGU1), 2, r, scr, F.lane, inp(A, 2)); continue; } r -= I_GU;
            if (r < I_D)  { conv_item(inp(A, 5), DFF, DM, wsp<bf16>(A, WS_WD1), 0, r, scr, F.lane); continue; } r -= I_D;
            if (r < I_IN) { conv_item(inp(A, 8), DM, INW, wsp<bf16>(A, WS_WIN), 0, r, scr, F.lane, inp(A, 7)); continue; } r -= I_IN;
            if (r < I_O)  { conv_item(inp(A, 25), DM, DM, wsp<bf16>(A, WS_WOUT), 0, r, scr, F.lane); continue; } r -= I_O;
            if (r < I_GU) { conv_item(inp(A, 28), DM, DFF, wsp<bf16>(A, WS_WGU2), 1, r, scr, F.lane, inp(A, 27)); continue; } r -= I_GU;
            if (r < I_GU) { conv_item(inp(A, 29), DM, DFF, wsp<bf16>(A, WS_WGU2), 2, r, scr, F.lane, inp(A, 27)); continue; } r -= I_GU;
            conv_item(inp(A, 30), DFF, DM, wsp<bf16>(A, WS_WD2), 0, r, scr, F.lane);
        }
        rope_table(F, wsp<float>(A, WS_ROPE));
        pre_rows(F, inp(A, 0), wsp<bf16>(A, WS_XN), wsp<float>(A, WS_RS), MH);
    }
    SEAM(0);
    trunk<0, LO, HI>(lds, bar);
    trunk<1, LO, HI>(lds, bar);
}
#undef IN
#undef SEAM

template <int LO, int HI> static bool launch_range(int grid, hipStream_t stream, const Args& a) {
    static int ok = 0;
    if (ok == 0) { ok = (hipFuncSetAttribute((const void*)hymba_fwd<LO, HI>, hipFuncAttributeMaxDynamicSharedMemorySize, LDS_BYTES) == hipSuccess) ? 1 : -1;
        if (ok < 0) fprintf(stderr, "kernel_launch: hipFuncSetAttribute failed for phases [%d, %d)\n", LO, HI); }
    if (ok < 0) return false;
    hipLaunchKernelGGL((hymba_fwd<LO, HI>), dim3(grid), dim3(NWAVES * 64), LDS_BYTES, stream, a);
    return true;
}
#if MK_PER_PHASE
template <int P> static void launch_from(int grid, hipStream_t stream, const Args& a) {
    if constexpr (P < N_PHASES) { launch_range<P, P + 1>(grid, stream, a); launch_from<P + 1>(grid, stream, a); }
}
#endif
extern "C" void kernel_launch(void* const* d_in, const int* in_sizes, int n_in, void* d_out, int out_size, void* d_ws, size_t ws_size, hipStream_t stream) {
    static int grid = 0;
    if (grid == 0) {
        if (n_in != 32 || in_sizes[0] != MH * DM || in_sizes[1] != MH * DM || out_size != 2 * MH * DM || ws_size < WS_END) {
            fprintf(stderr, "kernel_launch: unexpected shapes (n_in %d, out %d, ws %zu); nothing launched\n", n_in, out_size, ws_size); grid = -1; return; }
        int dev = 0, cus = 0;
        if (hipGetDevice(&dev) != hipSuccess || hipDeviceGetAttribute(&cus, hipDeviceAttributeMultiprocessorCount, dev) != hipSuccess) { grid = -1; return; }
        int per_cu = 0;
#if MK_PER_PHASE
        per_cu = 1;
#else
        if (hipFuncSetAttribute((const void*)hymba_fwd<0, N_PHASES>, hipFuncAttributeMaxDynamicSharedMemorySize, LDS_BYTES) != hipSuccess ||
            hipOccupancyMaxActiveBlocksPerMultiprocessor(&per_cu, (const void*)hymba_fwd<0, N_PHASES>, NWAVES * 64, LDS_BYTES) != hipSuccess || per_cu < 1) {
            fprintf(stderr, "kernel_launch: the occupancy query reports %d workgroups per CU for this kernel; launching one per CU anyway\n", per_cu); per_cu = 1; }
        (void)hipGetLastError();
#endif
        grid = cus * (per_cu < 1 ? per_cu : 1);
    }
    if (grid < 0) return;
    if (hipMemsetAsync((char*)d_ws + WS_CTL, 0, CTL_ZERO_BYTES, stream) != hipSuccess) return;
    Args a{};
    for (int i = 0; i < 32; ++i) a.in[i] = (unsigned long long)(uintptr_t)d_in[i];
    a.out = (unsigned long long)(uintptr_t)d_out; a.ws = (unsigned long long)(uintptr_t)d_ws;
    a.ph_lo = 0; a.ph_hi = N_PHASES;
#if MK_PER_PHASE
    launch_from<0>(grid, stream, a);
#else
    launch_range<0, N_PHASES>(grid, stream, a);
#endif
    const hipError_t le = hipPeekAtLastError();
    if (le != hipSuccess) fprintf(stderr, "kernel_launch: launch failed: %s\n", hipGetErrorName(le));
}
```

```cpp
#include <hip/hip_runtime.h>
#include <cstdio>
#include <cstdint>

#ifndef MK_PER_PHASE
#define MK_PER_PHASE 0
#endif

namespace pg8 {
#define PG8_LAS __attribute__((address_space(3)))
typedef unsigned short bf16_t;
typedef short bf16x8 __attribute__((ext_vector_type(8)));
typedef float f32x4 __attribute__((ext_vector_type(4)));
typedef unsigned u32x4 __attribute__((ext_vector_type(4)));
constexpr int BM = 256, BK = 64, HALF = 128, HTB = HALF * BK * 2  , STAGE_BYTES = 8 * HTB, NXCD = 8, WGM = 4;

__host__ __device__ __forceinline__ int lds_byte(int r, int c) { const int st = (r >> 4) * 2 + (c >> 5), rr = r & 15, cc = c & 31, ob = rr * 64 + cc * 2; return st * 1024 + (ob ^ (((ob >> 9) & 1) << 5)); }
__host__ __device__ __forceinline__ void stage_rc(int b, int& R, int& C) { const int st = b / 1024, sb = b % 1024, swz = sb ^ (((sb >> 9) & 1) << 5); R = (st >> 1) * 16 + swz / 64; C = (st & 1) * 32 + (swz % 64) / 2; }
__host__ __device__ __forceinline__ int perm32(int rho) { const int n = rho >> 4, i = rho & 15; return 8 * (i >> 2) + 4 * n + (i & 3); }

struct Unit { int pm, pn; };
struct Gemm { const bf16_t* A; const bf16_t* Bt; int M, N, K; };

struct StaticOrder {
    int nM, nN, nwg, G, c;
    __host__ __device__ void init(int M, int N, int G_, int c_) { nM = M / BM; nN = N / BM; nwg = nM * nN; G = G_; c = c_; }
    __host__ __device__ bool next(int i, Unit& u) const {
        const long L = (long)i * G + c; if (L >= nwg) return false;
        int wgid = (int)L; { const int q = nwg / NXCD, r = nwg % NXCD, xcd = wgid % NXCD, off = wgid / NXCD; wgid = (xcd < r ? xcd * (q + 1) : r * (q + 1) + (xcd - r) * q) + off; }
        const int nig = WGM * nN, gid = wgid / nig, fm = gid * WGM, gsz = (nM - fm) < WGM ? (nM - fm) : WGM;
        u.pm = fm + ((wgid % nig) % gsz); u.pn = (wgid % nig) / gsz; return true;
    }
    __device__ __forceinline__ void a_ready(const Unit&) const {}
    __device__ __forceinline__ void done(const Unit&) const {}
};

__device__ __forceinline__ unsigned cvt_pk_bf16(float lo, float hi) { unsigned r; asm volatile("v_cvt_pk_bf16_f32 %0, %1, %2" : "=v"(r) : "v"(lo), "v"(hi)); return r; }

struct EpiBf16 {
    static constexpr bool PERM = true, AFTER_DRAIN = false;
    bf16_t* O; int ldc; const float* rs;
    __device__ __forceinline__ void operator()(const f32x4 (&acc)[2][2][4][2], const Unit& u, int wr, int wc, int fr, int fq) const {
        const int row0 = u.pm * BM + wr * 64 + fr; const int col0 = u.pn * BM + wc * 32 + 8 * fq;
#pragma unroll
        for (int ai = 0; ai < 2; ++ai)
#pragma unroll
            for (int m = 0; m < 4; ++m) { const int row = row0 + ai * HALF + m * 16; bf16_t* rowp = O + (size_t)row * ldc + col0; const float s = rs ? rs[row] : 1.0f;
#pragma unroll
                for (int bj = 0; bj < 2; ++bj) { const f32x4 v0 = acc[ai][bj][m][0] * s, v1 = acc[ai][bj][m][1] * s;
                    u32x4 w; w.x = cvt_pk_bf16(v0[0], v0[1]); w.y = cvt_pk_bf16(v0[2], v0[3]); w.z = cvt_pk_bf16(v1[0], v1[1]); w.w = cvt_pk_bf16(v1[2], v1[3]);
                    *(u32x4*)(rowp + bj * HALF) = w; } }
    }
};
__device__ __forceinline__ float silu_mul(float g, float u) { const float e = __builtin_amdgcn_exp2f(g * -1.4426950408889634f); return g * u * __builtin_amdgcn_rcpf(1.0f + e); }
struct EpiSwiglu {
    static constexpr bool PERM = true, AFTER_DRAIN = false;
    bf16_t* O; int ldc; const float* rs;
    __device__ __forceinline__ void operator()(const f32x4 (&acc)[2][2][4][2], const Unit& u, int wr, int wc, int fr, int fq) const {
        const int row0 = u.pm * BM + wr * 64 + fr; const int col0 = u.pn * HALF + wc * 32 + 8 * fq;
#pragma unroll
        for (int ai = 0; ai < 2; ++ai)
#pragma unroll
            for (int m = 0; m < 4; ++m) { const int row = row0 + ai * HALF + m * 16; bf16_t* rowp = O + (size_t)row * ldc + col0; const float s = rs[row];
                const f32x4 g0 = acc[ai][0][m][0] * s, g1 = acc[ai][0][m][1] * s, u0 = acc[ai][1][m][0] * s, u1 = acc[ai][1][m][1] * s;
                u32x4 w; w.x = cvt_pk_bf16(silu_mul(g0[0], u0[0]), silu_mul(g0[1], u0[1])); w.y = cvt_pk_bf16(silu_mul(g0[2], u0[2]), silu_mul(g0[3], u0[3]));
                w.z = cvt_pk_bf16(silu_mul(g1[0], u1[0]), silu_mul(g1[1], u1[1])); w.w = cvt_pk_bf16(silu_mul(g1[2], u1[2]), silu_mul(g1[3], u1[3]));
                *(u32x4*)rowp = w; }
    }
};

template <class Epi, class Sched, bool ALIGN_EPI = false, bool SP2 = false>
__device__ __forceinline__ void gemm_phase(PG8_LAS unsigned char* lds, const Gemm g, const Sched& S, const Epi& E, const int tid) {
    const int wid = __builtin_amdgcn_readfirstlane(tid >> 6), lane = tid & 63, wr = wid >> 2, wc = wid & 3, fr = lane & 15, fq = lane >> 4;
    const int K = g.K, nt = K / BK;
    unsigned voffA[2], voffB[2];
#pragma unroll
    for (int i = 0; i < 2; ++i) { int R, C; stage_rc(tid * 16 + i * 8192, R, C); const int Rb = Epi::PERM ? ((R & ~31) + perm32(R & 31)) : R;
        voffA[i] = (unsigned)(R * K + C) * 2u; voffB[i] = (unsigned)(Rb * K + C) * 2u; }
    const size_t kstep = (size_t)(BK * 2);
    const size_t hstep = (size_t)HALF * K * 2;
    const size_t tstep = 2 * hstep;
    const unsigned ldsw = (unsigned)wid * 1024u;
    const int aoff = lds_byte(wr * 64 + fr, fq * 8), boff = lds_byte(wc * 32 + fr, fq * 8);
#define PG8_SA(b, h) (((b) * 2 + (h)) * HTB)
#define PG8_SB(b, h) ((4 + (b) * 2 + (h)) * HTB)
#define PG8_STAGE(bufoff, gbase, voff) do { _Pragma("unroll") for (int _i = 0; _i < 2; ++_i) \
        __builtin_amdgcn_global_load_lds((const unsigned*)((const char*)(gbase) + (voff)[_i]), (PG8_LAS unsigned*)(lds + (bufoff) + ldsw + _i * 8192), 16, 0, 0); } while (0)
#define PG8_LDA(dst, b, h) do { _Pragma("unroll") for (int m = 0; m < 4; ++m) _Pragma("unroll") for (int k = 0; k < 2; ++k) dst[m][k] = *(const PG8_LAS bf16x8*)(lds + PG8_SA(b, h) + aoff + m * 2048 + k * 1024); } while (0)
#define PG8_LDB(dst, b, h) do { _Pragma("unroll") for (int n = 0; n < 2; ++n) _Pragma("unroll") for (int k = 0; k < 2; ++k) dst[n][k] = *(const PG8_LAS bf16x8*)(lds + PG8_SB(b, h) + boff + n * 2048 + k * 1024); } while (0)
#define PG8_MMA(ai, bj, At, Bt) do { __builtin_amdgcn_s_setprio(1); _Pragma("unroll") for (int m = 0; m < 4; ++m) _Pragma("unroll") for (int n = 0; n < 2; ++n) _Pragma("unroll") for (int k = 0; k < 2; ++k) \
        acc[ai][bj][m][n] = __builtin_amdgcn_mfma_f32_16x16x32_bf16(Bt[n][k], At[m][k], acc[ai][bj][m][n], 0, 0, 0); __builtin_amdgcn_s_setprio(0); } while (0)
#define PG8_WAIT_V(n) asm volatile("s_waitcnt vmcnt(" #n ")" ::: "memory")
#define PG8_WAIT_L(n) asm volatile("s_waitcnt lgkmcnt(" #n ")" ::: "memory")
#define PG8_BAR __builtin_amdgcn_s_barrier()
#define PG8_SCHED __builtin_amdgcn_sched_barrier(0)
    Unit cur, nxt; int ui = 0;
    if (!S.next(0, cur)) return;
    f32x4 acc[2][2][4][2];
#pragma unroll
    for (int a = 0; a < 2; ++a)
#pragma unroll
        for (int b = 0; b < 2; ++b)
#pragma unroll
            for (int m = 0; m < 4; ++m)
#pragma unroll
                for (int n = 0; n < 2; ++n) acc[a][b][m][n] = (f32x4){0.f, 0.f, 0.f, 0.f};
    bf16x8 At[4][2], B0[2][2], B1[2][2];
    const char* cA = (const char*)g.A + (size_t)cur.pm * tstep; const char* cB = (const char*)g.Bt + (size_t)cur.pn * tstep;
    S.a_ready(cur);
    if constexpr (SP2) {
        PG8_STAGE(PG8_SB(0, 0), cB, voffB); PG8_STAGE(PG8_SB(0, 1), cB + hstep, voffB); PG8_STAGE(PG8_SA(0, 0), cA, voffA); PG8_STAGE(PG8_SA(0, 1), cA + hstep, voffA);
        if (wr == 1) PG8_BAR;
        PG8_WAIT_V(2); PG8_BAR;
        PG8_STAGE(PG8_SB(1, 0), cB + kstep, voffB); PG8_STAGE(PG8_SA(1, 0), cA + kstep, voffA); PG8_STAGE(PG8_SB(1, 1), cB + hstep + kstep, voffB);
        PG8_WAIT_V(6); PG8_BAR;
    } else {
        PG8_STAGE(PG8_SB(0, 0), cB, voffB); PG8_STAGE(PG8_SA(0, 0), cA, voffA); PG8_STAGE(PG8_SB(0, 1), cB + hstep, voffB); PG8_STAGE(PG8_SA(0, 1), cA + hstep, voffA);
        if (wr == 1) PG8_BAR;
        PG8_WAIT_V(4); PG8_BAR;
        PG8_STAGE(PG8_SB(1, 0), cB + kstep, voffB); PG8_STAGE(PG8_SA(1, 0), cA + kstep, voffA); PG8_STAGE(PG8_SB(1, 1), cB + hstep + kstep, voffB);
        PG8_WAIT_V(6); PG8_BAR;
    }
    for (;;) {
        const bool has_next = S.next(ui + 1, nxt);
        const char* nA = has_next ? (const char*)g.A + (size_t)nxt.pm * tstep : cA; const char* nB = has_next ? (const char*)g.Bt + (size_t)nxt.pn * tstep : cB;
        for (int t = 0; t < nt; t += 2) {
            const bool last = (t == nt - 2);
            const char* a1 = cA + (size_t)(t + 1) * kstep;
            const char* a2 = last ? nA : cA + (size_t)(t + 2) * kstep; const char* b2 = last ? nB : cB + (size_t)(t + 2) * kstep;
            const char* a3 = a2 + kstep; const char* b3 = b2 + kstep;
            if (last && has_next) S.a_ready(nxt);
            if constexpr (SP2) {
            PG8_LDB(B0, 0, 0); PG8_LDB(B1, 0, 1); PG8_SCHED; PG8_LDA(At, 0, 0); PG8_STAGE(PG8_SA(1, 1), a1 + hstep, voffA);
            PG8_WAIT_V(8); PG8_WAIT_L(0); PG8_BAR; PG8_MMA(0, 0, At, B0); PG8_MMA(0, 1, At, B1); PG8_BAR; PG8_SCHED;
            PG8_LDA(At, 0, 1); PG8_STAGE(PG8_SB(0, 0), b2, voffB); PG8_STAGE(PG8_SB(0, 1), b2 + hstep, voffB); PG8_STAGE(PG8_SA(0, 0), a2, voffA);
            PG8_WAIT_V(8); PG8_WAIT_L(0); PG8_BAR; PG8_MMA(1, 0, At, B0); PG8_MMA(1, 1, At, B1); PG8_BAR; PG8_SCHED;
            PG8_LDB(B0, 1, 0); PG8_LDB(B1, 1, 1); PG8_SCHED; PG8_LDA(At, 1, 0); PG8_STAGE(PG8_SA(0, 1), a2 + hstep, voffA);
            PG8_WAIT_V(8); PG8_WAIT_L(0); PG8_BAR; PG8_MMA(0, 0, At, B0); PG8_MMA(0, 1, At, B1); PG8_BAR; PG8_SCHED;
            PG8_LDA(At, 1, 1); PG8_STAGE(PG8_SB(1, 0), b3, voffB); PG8_STAGE(PG8_SB(1, 1), b3 + hstep, voffB); PG8_STAGE(PG8_SA(1, 0), a3, voffA);
            PG8_WAIT_V(8); PG8_WAIT_L(0); PG8_BAR; PG8_MMA(1, 0, At, B0); PG8_MMA(1, 1, At, B1); PG8_BAR; PG8_SCHED;
            } else {
            PG8_LDB(B0, 0, 0); PG8_SCHED; PG8_LDA(At, 0, 0); PG8_STAGE(PG8_SA(1, 1), a1 + hstep, voffA);
            PG8_WAIT_L(8); PG8_BAR; PG8_WAIT_L(0); PG8_MMA(0, 0, At, B0); PG8_BAR; PG8_SCHED;
            PG8_LDB(B1, 0, 1); PG8_STAGE(PG8_SB(0, 0), b2, voffB);
            PG8_BAR; PG8_WAIT_L(0); PG8_MMA(0, 1, At, B1); PG8_BAR;
            PG8_LDA(At, 0, 1); PG8_STAGE(PG8_SA(0, 0), a2, voffA);
            PG8_BAR; PG8_WAIT_L(0); PG8_MMA(1, 0, At, B0); PG8_BAR; PG8_SCHED;
            PG8_STAGE(PG8_SB(0, 1), b2 + hstep, voffB);
            PG8_WAIT_V(6); PG8_BAR; PG8_MMA(1, 1, At, B1); PG8_BAR;
            PG8_LDB(B0, 1, 0); PG8_SCHED; PG8_LDA(At, 1, 0); PG8_STAGE(PG8_SA(0, 1), a2 + hstep, voffA);
            PG8_WAIT_L(8); PG8_BAR; PG8_WAIT_L(0); PG8_MMA(0, 0, At, B0); PG8_BAR; PG8_SCHED;
            PG8_LDB(B1, 1, 1); PG8_STAGE(PG8_SB(1, 0), b3, voffB);
            PG8_BAR; PG8_WAIT_L(0); PG8_MMA(0, 1, At, B1); PG8_BAR;
            PG8_LDA(At, 1, 1); PG8_STAGE(PG8_SA(1, 0), a3, voffA);
            PG8_BAR; PG8_WAIT_L(0); PG8_MMA(1, 0, At, B0); PG8_BAR; PG8_SCHED;
            PG8_STAGE(PG8_SB(1, 1), b3 + hstep, voffB);
            PG8_WAIT_V(6); PG8_BAR; PG8_MMA(1, 1, At, B1); PG8_BAR;
            }
        }
        if constexpr (ALIGN_EPI) { if (wr == 0) PG8_BAR; }
        E(acc, cur, wr, wc, fr, fq); S.done(cur);
        if (!has_next) break;
#pragma unroll
        for (int a = 0; a < 2; ++a)
#pragma unroll
            for (int b = 0; b < 2; ++b)
#pragma unroll
                for (int m = 0; m < 4; ++m)
#pragma unroll
                    for (int n = 0; n < 2; ++n) acc[a][b][m][n] = (f32x4){0.f, 0.f, 0.f, 0.f};
        cur = nxt; cA = nA; cB = nB; ++ui;
        if constexpr (ALIGN_EPI) { if (wr == 1) PG8_BAR; }
    }
    PG8_WAIT_V(0);
    if constexpr (!ALIGN_EPI) { if (wr == 0) PG8_BAR; }
    PG8_BAR;
#undef PG8_SA
#undef PG8_SB
#undef PG8_STAGE
#undef PG8_LDA
#undef PG8_LDB
#undef PG8_MMA
#undef PG8_WAIT_V
#undef PG8_WAIT_L
#undef PG8_BAR
#undef PG8_SCHED
}
}

namespace att {
typedef unsigned short bf16;
constexpr int D = 128, NW = 8, QBLK = 32, KVBLK = 64;
constexpr float SCALE = 0.088388347648318440f;
constexpr float THR = 8.f;
#ifndef ATT_MFMA16
#define ATT_MFMA16 1
#endif
#ifndef ATT_RING
#define ATT_RING 1
#endif
#ifndef ATT_SDEPTH_FIX
#define ATT_SDEPTH_FIX 2
#endif
constexpr int LDQ = 3584, LDK = 3584, LDO = 3584;
constexpr size_t SHM_V = KVBLK * D * 2, SHM_K = KVBLK * D * 2, SHM_ATTN = 2 * SHM_V + 2 * SHM_K + NW * 64 * 4;
using bf16x8 = __attribute__((ext_vector_type(8))) short;
using s16x4  = __attribute__((ext_vector_type(4))) short;
using f32x16 = __attribute__((ext_vector_type(16))) float;
using u32x4  = __attribute__((ext_vector_type(4))) unsigned;
using f32x4  = __attribute__((ext_vector_type(4))) float;
#define KSWZ(row, colB) ((row) * 256 + ((colB) ^ (((row) & 15) << 4)))
#define SBAR() __builtin_amdgcn_sched_barrier(0)
__device__ __forceinline__ int crow(int r, int hi) { return (r & 3) + 8 * (r >> 2) + 4 * hi; }
__device__ __forceinline__ unsigned cvtpk(float lo, float hi) { unsigned r; asm volatile("v_cvt_pk_bf16_f32 %0, %1, %2" : "=v"(r) : "v"(lo), "v"(hi)); return r; }

template <bool FIXM>
__device__ __forceinline__ void partialSM(f32x16& p0, f32x16& p1, float& m_reg, float& mn, float& alpha) {
  constexpr float C = SCALE * 1.4426950408889634f;
  if constexpr (FIXM) { alpha = 1.f;
    return; }
  float pmax = p0[0];
#pragma unroll
  for (int r = 1; r < 16; ++r) pmax = fmaxf(pmax, p0[r]);
#pragma unroll
  for (int r = 0; r < 16; ++r) pmax = fmaxf(pmax, p1[r]);
  { auto rr = __builtin_amdgcn_permlane32_swap(__float_as_uint(pmax), __float_as_uint(pmax), false, false);
    pmax = fmaxf(__uint_as_float(rr[0]), __uint_as_float(rr[1])); }
  if (__builtin_expect(__all(pmax - m_reg <= THR / SCALE), 1)) { mn = m_reg; alpha = 1.f; }
  else { mn = fmaxf(m_reg, pmax); alpha = __builtin_amdgcn_exp2f((m_reg - mn) * C); m_reg = mn; }
  float mnC = -mn * C;
#pragma unroll
  for (int r = 0; r < 16; ++r) p0[r] = fmaf(p0[r], C, mnC);
#pragma unroll
  for (int r = 0; r < 16; ++r) p1[r] = fmaf(p1[r], C, mnC);
#pragma unroll
  for (int r = 0; r < 16; ++r) p0[r] = __builtin_amdgcn_exp2f(p0[r]);
}
template <bool FIXM, bool P0DONE = false>
__device__ __forceinline__ void finishSM(f32x16& p0, f32x16& p1, float alpha, float& l_reg, bf16x8& pa0, bf16x8& pa1, bf16x8& pa2, bf16x8& pa3) {
  if constexpr (FIXM && !P0DONE) {
#pragma unroll
    for (int r = 0; r < 16; ++r) p0[r] = __builtin_amdgcn_exp2f(p0[r]); }
#pragma unroll
  for (int r = 0; r < 16; ++r) p1[r] = __builtin_amdgcn_exp2f(p1[r]);
  float ps = 0;
#pragma unroll
  for (int r = 0; r < 16; ++r) ps += p0[r];
#pragma unroll
  for (int r = 0; r < 16; ++r) ps += p1[r];
  { auto rr = __builtin_amdgcn_permlane32_swap(__float_as_uint(ps), __float_as_uint(ps), false, false);
    ps = __uint_as_float(rr[0]) + __uint_as_float(rr[1]); }
  l_reg = l_reg * alpha + ps;
#define PK4(P, BASE, OUT) do { unsigned a0 = cvtpk(P[BASE + 0], P[BASE + 1]), a1 = cvtpk(P[BASE + 2], P[BASE + 3]);   \
    unsigned b0 = cvtpk(P[BASE + 4], P[BASE + 5]), b1 = cvtpk(P[BASE + 6], P[BASE + 7]);                              \
    auto r0 = __builtin_amdgcn_permlane32_swap(a0, b0, false, false); auto r1 = __builtin_amdgcn_permlane32_swap(a1, b1, false, false); \
    u32x4 w = {r0[0], r1[0], r0[1], r1[1]}; OUT = *reinterpret_cast<bf16x8*>(&w); } while (0)
  PK4(p0, 0, pa0); PK4(p0, 8, pa1); PK4(p1, 0, pa2); PK4(p1, 8, pa3);
#undef PK4
}
__device__ __forceinline__ void qkt(f32x16& p0, f32x16& p1, const bf16* Ks, const bf16x8* qr, int r32, int hi) {
  p0 = f32x16{}; p1 = f32x16{};
#pragma unroll
  for (int d0 = 0; d0 < 8; ++d0) { int cb = (d0 * 16 + hi * 8) * 2;
    bf16x8 b0 = *reinterpret_cast<const bf16x8*>((const char*)Ks + KSWZ(r32, cb));
    bf16x8 b1 = *reinterpret_cast<const bf16x8*>((const char*)Ks + KSWZ(32 + r32, cb));
    p0 = __builtin_amdgcn_mfma_f32_32x32x16_bf16(b0, qr[d0], p0, 0, 0, 0);
    p1 = __builtin_amdgcn_mfma_f32_32x32x16_bf16(b1, qr[d0], p1, 0, 0, 0); }
}
__device__ __forceinline__ int v_st(int k, int c) { const int kk = (k & ~0xC) | ((k & 4) << 1) | ((k & 8) >> 1); return ((kk >> 3) * 4 + (c >> 5)) * 512 + ((kk & 7) * 32 + (c & 31)) * 2; }
__device__ __forceinline__ int v_rd_base(int lane) { return ((lane & 3) << 3) | (((lane >> 2) & 3) << 6) | (((lane >> 4) & 1) << 5) | (((lane >> 5) & 1) << 8); }
constexpr int v_rd_off(int d0, int ks, int half) { return d0 * 512 + ks * 4096 + half * 2048; }
template <int OFF> __device__ __forceinline__ s16x4 tr_read(int vb) {
  s16x4 r; asm volatile("ds_read_b64_tr_b16 %0, %1 offset:%2" : "=&v"(r) : "v"(vb), "i"(OFF) : "memory"); return r;
}
template <int D0> __device__ __forceinline__ void pv_one(f32x16& od, int vb, bf16x8 pa0, bf16x8 pa1, bf16x8 pa2, bf16x8 pa3) {
  const s16x4 l0 = tr_read<v_rd_off(D0, 0, 0)>(vb), h0 = tr_read<v_rd_off(D0, 0, 1)>(vb), l1 = tr_read<v_rd_off(D0, 1, 0)>(vb), h1 = tr_read<v_rd_off(D0, 1, 1)>(vb);
  const s16x4 l2 = tr_read<v_rd_off(D0, 2, 0)>(vb), h2 = tr_read<v_rd_off(D0, 2, 1)>(vb), l3 = tr_read<v_rd_off(D0, 3, 0)>(vb), h3 = tr_read<v_rd_off(D0, 3, 1)>(vb);
  asm volatile("s_waitcnt lgkmcnt(0)" ::: "memory"); SBAR();
#define PK(L, H) (bf16x8){L[0], L[1], L[2], L[3], H[0], H[1], H[2], H[3]}
  od = __builtin_amdgcn_mfma_f32_32x32x16_bf16(pa0, PK(l0, h0), od, 0, 0, 0);
  od = __builtin_amdgcn_mfma_f32_32x32x16_bf16(pa1, PK(l1, h1), od, 0, 0, 0);
  od = __builtin_amdgcn_mfma_f32_32x32x16_bf16(pa2, PK(l2, h2), od, 0, 0, 0);
  od = __builtin_amdgcn_mfma_f32_32x32x16_bf16(pa3, PK(l3, h3), od, 0, 0, 0);
#undef PK
}
template <int D0> __device__ __forceinline__ void pv_one_x(f32x16& od, int vb, bf16x8 pa0, bf16x8 pa1, bf16x8 pa2, bf16x8 pa3, f32x16& px) {
  const s16x4 l0 = tr_read<v_rd_off(D0, 0, 0)>(vb), h0 = tr_read<v_rd_off(D0, 0, 1)>(vb), l1 = tr_read<v_rd_off(D0, 1, 0)>(vb), h1 = tr_read<v_rd_off(D0, 1, 1)>(vb);
  const s16x4 l2 = tr_read<v_rd_off(D0, 2, 0)>(vb), h2 = tr_read<v_rd_off(D0, 2, 1)>(vb), l3 = tr_read<v_rd_off(D0, 3, 0)>(vb), h3 = tr_read<v_rd_off(D0, 3, 1)>(vb);
  asm volatile("s_waitcnt lgkmcnt(0)" ::: "memory"); SBAR();
#define PK(L, H) (bf16x8){L[0], L[1], L[2], L[3], H[0], H[1], H[2], H[3]}
  od = __builtin_amdgcn_mfma_f32_32x32x16_bf16(pa0, PK(l0, h0), od, 0, 0, 0); px[4 * D0 + 0] = __builtin_amdgcn_exp2f(px[4 * D0 + 0]);
  od = __builtin_amdgcn_mfma_f32_32x32x16_bf16(pa1, PK(l1, h1), od, 0, 0, 0); px[4 * D0 + 1] = __builtin_amdgcn_exp2f(px[4 * D0 + 1]);
  od = __builtin_amdgcn_mfma_f32_32x32x16_bf16(pa2, PK(l2, h2), od, 0, 0, 0); px[4 * D0 + 2] = __builtin_amdgcn_exp2f(px[4 * D0 + 2]);
  od = __builtin_amdgcn_mfma_f32_32x32x16_bf16(pa3, PK(l3, h3), od, 0, 0, 0); px[4 * D0 + 3] = __builtin_amdgcn_exp2f(px[4 * D0 + 3]);
#undef PK
}
__device__ __forceinline__ void pv_d0_x(f32x16* o, int vb, bf16x8 pa0, bf16x8 pa1, bf16x8 pa2, bf16x8 pa3, f32x16& px) {
  pv_one_x<0>(o[0], vb, pa0, pa1, pa2, pa3, px); pv_one_x<1>(o[1], vb, pa0, pa1, pa2, pa3, px); pv_one_x<2>(o[2], vb, pa0, pa1, pa2, pa3, px); pv_one_x<3>(o[3], vb, pa0, pa1, pa2, pa3, px);
}
__device__ __forceinline__ void pv_d0(f32x16* o, int vb, bf16x8 pa0, bf16x8 pa1, bf16x8 pa2, bf16x8 pa3) {
  pv_one<0>(o[0], vb, pa0, pa1, pa2, pa3); pv_one<1>(o[1], vb, pa0, pa1, pa2, pa3); pv_one<2>(o[2], vb, pa0, pa1, pa2, pa3); pv_one<3>(o[3], vb, pa0, pa1, pa2, pa3);
}
__device__ __forceinline__ unsigned short f2bf_rne(float f) { unsigned u = __float_as_uint(f); u += 0x7FFFu + ((u >> 16) & 1u); return (unsigned short)(u >> 16); }

#ifndef ATT_SPLITX
#define ATT_SPLITX 0
#endif
#ifndef ATT_STAGGER
#define ATT_STAGGER 0
#endif
template <bool FIXM, int NTT>
__device__ __forceinline__ void attn_unit(const bf16* Qb, const bf16* Kh, const bf16* Vh, bf16* Ob, int seq, char* lds, PG8_LAS unsigned char* ldsl, const int tid, const float mfix,
                                          const float* gqp, const float* tab, const int t0, const float qmul) {
  const int wid = tid >> 6, lane = tid & 63, r32 = lane & 31, hi = lane >> 5;
  constexpr bool RING = FIXM && ATT_RING;
  constexpr int NB = RING ? 3 : 2;
  static_assert(!RING || (NTT % 2 == 0 && (NTT - 1) % 6 == 3), "ring loop: the tile count must leave exactly three steps after the six-step body");
  bf16* V_lds = (bf16*)(RING ? lds + NB * SHM_K : lds); bf16* K_lds = (bf16*)(RING ? lds : lds + NB * SHM_V);
  float* ws = (float*)(lds + NB * SHM_V + NB * SHM_K) + wid * 64; float* li_l = ws; float* al_l = ws + 32;
  float m_reg = FIXM ? mfix : -1e30f, l_reg = 0; f32x16 o[4] = {}; bf16x8 qr[8];
  const bf16* Qw = Qb + (long)(wid * QBLK + r32) * LDQ + hi * 8;
#pragma unroll
  for (int d0 = 0; d0 < 8; ++d0) qr[d0] = *reinterpret_cast<const bf16x8*>(Qw + d0 * 16);
  if constexpr (FIXM) {
    float qf[8][8]; float ss = 0.f;
#pragma unroll
    for (int d0 = 0; d0 < 8; ++d0) { const u32x4 w = __builtin_bit_cast(u32x4, qr[d0]);
      qf[d0][0] = __uint_as_float(w.x << 16); qf[d0][1] = __uint_as_float(w.x & 0xffff0000u); qf[d0][2] = __uint_as_float(w.y << 16); qf[d0][3] = __uint_as_float(w.y & 0xffff0000u);
      qf[d0][4] = __uint_as_float(w.z << 16); qf[d0][5] = __uint_as_float(w.z & 0xffff0000u); qf[d0][6] = __uint_as_float(w.w << 16); qf[d0][7] = __uint_as_float(w.w & 0xffff0000u);
#pragma unroll
      for (int j = 0; j < 8; ++j) ss += qf[d0][j] * qf[d0][j]; }
    { auto rr = __builtin_amdgcn_permlane32_swap(__float_as_uint(ss), __float_as_uint(ss), false, false); ss = __uint_as_float(rr[0]) + __uint_as_float(rr[1]); }
    const float rs = __builtin_amdgcn_rsqf(ss * (1.0f / 128) + 1e-6f) * qmul;
    const int t = t0 + wid * QBLK + r32;
#pragma unroll
    for (int d0 = 0; d0 < 8; ++d0) { const float* gp = gqp + 16 * d0 + 8 * hi; const float4 g0 = *reinterpret_cast<const float4*>(gp), g1 = *reinterpret_cast<const float4*>(gp + 4);
      qf[d0][0] *= rs * g0.x; qf[d0][1] *= rs * g0.y; qf[d0][2] *= rs * g0.z; qf[d0][3] *= rs * g0.w; qf[d0][4] *= rs * g1.x; qf[d0][5] *= rs * g1.y; qf[d0][6] *= rs * g1.z; qf[d0][7] *= rs * g1.w; }
#pragma unroll
    for (int ax = 0; ax < 2; ++ax) { const int pos = ax ? (t & 63) : (t >> 6);
#pragma unroll
      for (int b = 0; b < 2; ++b) { const int da = 4 * ax + b, db = da + 2;
        const float4* tp = reinterpret_cast<const float4*>(tab + (size_t)(pos * 32 + 16 * b + 8 * hi) * 2);
#pragma unroll
        for (int j2 = 0; j2 < 4; ++j2) { const float4 cs = tp[j2];
          { const float x1 = qf[da][2 * j2], x2 = qf[db][2 * j2]; qf[da][2 * j2] = x1 * cs.x - x2 * cs.y; qf[db][2 * j2] = x2 * cs.x + x1 * cs.y; }
          { const float x1 = qf[da][2 * j2 + 1], x2 = qf[db][2 * j2 + 1]; qf[da][2 * j2 + 1] = x1 * cs.z - x2 * cs.w; qf[db][2 * j2 + 1] = x2 * cs.z + x1 * cs.w; } } } }
#pragma unroll
    for (int d0 = 0; d0 < 8; ++d0) { u32x4 w = {cvtpk(qf[d0][0], qf[d0][1]), cvtpk(qf[d0][2], qf[d0][3]), cvtpk(qf[d0][4], qf[d0][5]), cvtpk(qf[d0][6], qf[d0][7])}; qr[d0] = __builtin_bit_cast(bf16x8, w); }
  }
  int sr = tid >> 4; asm volatile("" : "+v"(sr));
  const int sc = (tid & 15) * 8, vst0 = v_st(sr, sc), vst1 = v_st(32 + sr, sc);
  const int vb0 = (int)(uintptr_t)V_lds + v_rd_base(lane);
  f32x16 pA0, pA1, pB0, pB1; bf16x8 pa0, pa1, pa2, pa3;
  if constexpr (RING) {
    const int widu = __builtin_amdgcn_readfirstlane(wid);
    const int krow = 4 * widu + (lane >> 4), kk_ = ((widu >> 1) << 3) | ((lane >> 2) & 7), vkey = (kk_ & ~0xC) | ((kk_ & 4) << 1) | ((kk_ & 8) >> 1);
    const unsigned koff = (unsigned)(krow * LDK + (((lane & 15) ^ (krow & 15)) << 3)) * 2u;
    const unsigned voff = (unsigned)(vkey * LDK + ((((2 * widu + (lane >> 5)) & 3) << 5) + ((lane & 3) << 3)) + (int)(Vh - Kh)) * 2u;
    PG8_LAS unsigned char* const dK = ldsl + widu * 1024; PG8_LAS unsigned char* const dV = ldsl + 3 * SHM_K + widu * 1024;
#define RDMA(b, k0) do { const char* g_ = (const char*)(Kh + (long)(k0) * LDK); const char* g2_ = g_ + 64L * LDK; \
    __builtin_amdgcn_global_load_lds((const unsigned*)(g_ + koff), (PG8_LAS unsigned*)(dK + (b) * SHM_K), 16, 0, 0); \
    __builtin_amdgcn_global_load_lds((const unsigned*)(g2_ + koff), (PG8_LAS unsigned*)(dK + (b) * SHM_K + 8192), 16, 0, 0); \
    __builtin_amdgcn_global_load_lds((const unsigned*)(g_ + voff), (PG8_LAS unsigned*)(dV + (b) * SHM_V), 16, 0, 0); \
    __builtin_amdgcn_global_load_lds((const unsigned*)(g2_ + voff), (PG8_LAS unsigned*)(dV + (b) * SHM_V + 8192), 16, 0, 0); } while (0)
#define RSYNC() do { asm volatile("s_waitcnt vmcnt(0)" ::: "memory"); __syncthreads(); } while (0)
#if ATT_SPLITX
#define RFIN(PO0, PO1) finishSM<true, true>(PO0, PO1, 1.f, l_reg, pa0, pa1, pa2, pa3)
#define RPV(VP, PN0) pv_d0_x(o, vb0 + (VP) * (int)SHM_V, pa0, pa1, pa2, pa3, PN0)
#else
#define RFIN(PO0, PO1) finishSM<true>(PO0, PO1, 1.f, l_reg, pa0, pa1, pa2, pa3)
#define RPV(VP, PN0) pv_d0(o, vb0 + (VP) * (int)SHM_V, pa0, pa1, pa2, pa3)
#endif
#define RSTEP(PN0, PN1, PO0, PO1, KC, VP, WN, WR, T) do { \
    if (WR) { if (!ATT_STAGGER || early) RDMA(WN, ((T) + 1) * KVBLK); } \
    SBAR(); qkt(PN0, PN1, (bf16*)((char*)K_lds + (KC) * SHM_K), qr, r32, hi); \
    RFIN(PO0, PO1); SBAR(); \
    if (WR) { if (ATT_STAGGER && !early) RDMA(WN, ((T) + 1) * KVBLK); } SBAR(); \
    RPV(VP, PN0); \
    RSYNC(); } while (0)
    const bool early = widu < 4;
    __syncthreads();
    RDMA(0, 0); RSYNC();
    RDMA(1, KVBLK); SBAR(); qkt(pA0, pA1, K_lds, qr, r32, hi);
#if ATT_SPLITX
    _Pragma("unroll") for (int r = 0; r < 16; ++r) pA0[r] = __builtin_amdgcn_exp2f(pA0[r]);
#endif
    RSYNC();
    for (int t = 1; t < NTT - 3; t += 6) {
      RSTEP(pB0, pB1, pA0, pA1, 1, 0, 2, true, t);
      RSTEP(pA0, pA1, pB0, pB1, 2, 1, 0, true, t + 1);
      RSTEP(pB0, pB1, pA0, pA1, 0, 2, 1, true, t + 2);
      RSTEP(pA0, pA1, pB0, pB1, 1, 0, 2, true, t + 3);
      RSTEP(pB0, pB1, pA0, pA1, 2, 1, 0, true, t + 4);
      RSTEP(pA0, pA1, pB0, pB1, 0, 2, 1, true, t + 5);
    }
    RSTEP(pB0, pB1, pA0, pA1, 1, 0, 2, true, NTT - 3);
    RSTEP(pA0, pA1, pB0, pB1, 2, 1, 0, true, NTT - 2);
    RSTEP(pB0, pB1, pA0, pA1, 0, 2, 1, false, NTT - 1);
    RFIN(pB0, pB1); SBAR();
    pv_d0(o, vb0, pa0, pa1, pa2, pa3);
#undef RDMA
#undef RSYNC
#undef RSTEP
#undef RFIN
#undef RPV
  } else {
  constexpr int SDEPTH = FIXM ? ATT_SDEPTH_FIX : 2;
  struct { bf16x8 vs0, vs1, ks0, ks1; } sr_[SDEPTH];
#define SLOAD(i, k0) do { sr_[i].vs0 = *reinterpret_cast<const bf16x8*>(&Vh[(long)((k0) + sr) * LDK + sc]); sr_[i].vs1 = *reinterpret_cast<const bf16x8*>(&Vh[(long)((k0) + 32 + sr) * LDK + sc]); \
    sr_[i].ks0 = *reinterpret_cast<const bf16x8*>(&Kh[(long)((k0) + sr) * LDK + sc]); sr_[i].ks1 = *reinterpret_cast<const bf16x8*>(&Kh[(long)((k0) + 32 + sr) * LDK + sc]); } while (0)
#define SWRITE(b, i) do { *(bf16x8*)((char*)V_lds + (b) * SHM_V + vst0) = sr_[i].vs0;          \
    *(bf16x8*)((char*)V_lds + (b) * SHM_V + vst1) = sr_[i].vs1; int kc = sc * 2;               \
    *(bf16x8*)((char*)K_lds + (b) * SHM_K + KSWZ(sr, kc)) = sr_[i].ks0;                       \
    *(bf16x8*)((char*)K_lds + (b) * SHM_K + KSWZ(32 + sr, kc)) = sr_[i].ks1; } while (0)
#define SWAIT() do { if constexpr (SDEPTH == 2) asm volatile("s_waitcnt vmcnt(4)" ::: "memory"); else asm volatile("s_waitcnt vmcnt(0)" ::: "memory"); } while (0)
#define RESC(a) do { if (!FIXM && __any((a) < 1.f)) { if (hi == 0) al_l[r32] = (a); asm volatile("s_waitcnt lgkmcnt(0)" ::: "memory"); \
    _Pragma("unroll") for (int d = 0; d < 4; ++d) _Pragma("unroll") for (int r = 0; r < 16; ++r) o[d][r] *= al_l[crow(r, hi)]; } } while (0)
  float mnA, mnB, alA, alB; const int NT = seq / KVBLK;
  constexpr int SE = 0, SO = SDEPTH - 1;
  SLOAD(SE, 0); asm volatile("s_waitcnt vmcnt(0)" ::: "memory"); SWRITE(0, SE); __syncthreads();
  qkt(pA0, pA1, K_lds, qr, r32, hi); partialSM<FIXM>(pA0, pA1, m_reg, mnA, alA);
  SLOAD(SO, KVBLK); if constexpr (SDEPTH == 2) { if (2 < NT) SLOAD(SE, 2 * KVBLK); }
  SWAIT(); SWRITE(1, SO); __syncthreads();
  for (int j = 1; j + 1 < NT; j += 2) {
    SBAR(); qkt(pB0, pB1, (bf16*)((char*)K_lds + SHM_K), qr, r32, hi);
    finishSM<FIXM>(pA0, pA1, alA, l_reg, pa0, pa1, pa2, pa3); SBAR();
    SLOAD(SO, (j + SDEPTH) * KVBLK); SBAR();
    pv_d0(o, vb0, pa0, pa1, pa2, pa3); partialSM<FIXM>(pB0, pB1, m_reg, mnB, alB);
    __syncthreads(); SWAIT(); SWRITE(0, SE);
    RESC(alB); __syncthreads();
    SBAR(); qkt(pA0, pA1, K_lds, qr, r32, hi);
    finishSM<FIXM>(pB0, pB1, alB, l_reg, pa0, pa1, pa2, pa3); SBAR();
    if (SDEPTH == 1 || j + 3 < NT) SLOAD(SE, (j + 1 + SDEPTH) * KVBLK); SBAR();
    pv_d0(o, vb0 + (int)SHM_V, pa0, pa1, pa2, pa3); partialSM<FIXM>(pA0, pA1, m_reg, mnA, alA);
    __syncthreads(); SWAIT(); SWRITE(1, SO);
    RESC(alA); __syncthreads();
  }
  SBAR(); qkt(pB0, pB1, (bf16*)((char*)K_lds + SHM_K), qr, r32, hi);
  finishSM<FIXM>(pA0, pA1, alA, l_reg, pa0, pa1, pa2, pa3); SBAR();
  pv_d0(o, vb0, pa0, pa1, pa2, pa3); partialSM<FIXM>(pB0, pB1, m_reg, mnB, alB);
  __syncthreads(); RESC(alB);
  finishSM<FIXM>(pB0, pB1, alB, l_reg, pa0, pa1, pa2, pa3); SBAR();
  pv_d0(o, vb0 + (int)SHM_V, pa0, pa1, pa2, pa3);
  }
  if (hi == 0) li_l[r32] = l_reg; asm volatile("s_waitcnt lgkmcnt(0)" ::: "memory");
  float rli[16];
#pragma unroll
  for (int r = 0; r < 16; ++r) rli[r] = __builtin_amdgcn_rcpf(li_l[crow(r, hi)]);
  const int odd = r32 & 1; bf16* Ow = Ob + (long)(wid * QBLK + 4 * hi + odd) * LDO + (r32 & ~1);
  asm volatile("" : "+v"(Ow));
#pragma unroll
  for (int d0 = 0; d0 < 4; ++d0)
#pragma unroll
    for (int i = 0; i < 8; ++i) { float v0 = o[d0][2 * i] * rli[2 * i], v1 = o[d0][2 * i + 1] * rli[2 * i + 1];
      asm volatile("" : "+v"(v0), "+v"(v1));
      const float send = odd ? v0 : v1;
      const float recv = __builtin_bit_cast(float, __builtin_amdgcn_update_dpp(0, __builtin_bit_cast(int, send), 0xB1, 0xF, 0xF, true));
      const unsigned w = cvtpk(odd ? recv : v0, odd ? v1 : recv);
      *(unsigned*)(Ow + (long)(((2 * i) & 3) + 8 * ((2 * i) >> 2)) * LDO + d0 * 32) = w; }
#undef SLOAD
#undef SWRITE
#undef SWAIT
#undef RESC
}

struct S16 { f32x4 t[4][2]; };
template <int OFF> __device__ __forceinline__ bf16x8 k_read(int a) { bf16x8 r; asm volatile("ds_read_b128 %0, %1 offset:%2" : "=&v"(r) : "v"(a), "i"(OFF) : "memory"); return r; }
typedef __bf16 bf16x2_n __attribute__((ext_vector_type(2))); typedef float f32x2_n __attribute__((ext_vector_type(2)));
__device__ __forceinline__ unsigned cvtpk_n(float lo, float hi) { const f32x2_n v = {lo, hi}; return __builtin_bit_cast(unsigned, __builtin_convertvector(v, bf16x2_n)); }
template <int KT> __device__ __forceinline__ void fin16_part(S16& p, float (&l)[2], bf16x8 (&pb)[2][2]) {
#pragma unroll
  for (int qt = 0; qt < 2; ++qt)
#pragma unroll
    for (int r = 0; r < 4; ++r) { p.t[KT][qt][r] = __builtin_amdgcn_exp2f(p.t[KT][qt][r]); l[qt] += p.t[KT][qt][r]; }
  if constexpr (KT & 1) {
#pragma unroll
    for (int qt = 0; qt < 2; ++qt) { const f32x4 a = p.t[KT - 1][qt], b = p.t[KT][qt];
      u32x4 w = {cvtpk_n(a[0], a[1]), cvtpk_n(a[2], a[3]), cvtpk_n(b[0], b[1]), cvtpk_n(b[2], b[3])}; pb[qt][KT >> 1] = __builtin_bit_cast(bf16x8, w); } }
}
__device__ __forceinline__ void finish16(S16& p, float (&l)[2], bf16x8 (&pb)[2][2]) { fin16_part<0>(p, l, pb); fin16_part<1>(p, l, pb); fin16_part<2>(p, l, pb); fin16_part<3>(p, l, pb); }
#define QK16_MMA(F, KS) do { _Pragma("unroll") for (int kt = 0; kt < 4; ++kt) { \
    s.t[kt][0] = __builtin_amdgcn_mfma_f32_16x16x32_bf16(F[kt], qr[0][KS], s.t[kt][0], 0, 0, 0); \
    s.t[kt][1] = __builtin_amdgcn_mfma_f32_16x16x32_bf16(F[kt], qr[1][KS], s.t[kt][1], 0, 0, 0); } } while (0)
#define QK16_RD(F, KS) do { F[0] = k_read<KC * 16384>(ka[KS]); F[1] = k_read<KC * 16384 + 4096>(ka[KS]); F[2] = k_read<KC * 16384 + 8192>(ka[KS]); F[3] = k_read<KC * 16384 + 12288>(ka[KS]); } while (0)
#define QK16_WAIT(F) do { asm volatile("s_waitcnt lgkmcnt(0)" : "+v"(F[0]), "+v"(F[1]), "+v"(F[2]), "+v"(F[3]), "+v"(s.t[0][0]), "+v"(s.t[0][1]), "+v"(s.t[1][0]), "+v"(s.t[1][1]), \
    "+v"(s.t[2][0]), "+v"(s.t[2][1]), "+v"(s.t[3][0]), "+v"(s.t[3][1]) :: "memory"); SBAR(); } while (0)
template <int KC, bool FIN> __device__ __forceinline__ void qk16(S16& s, S16& po, float (&l)[2], bf16x8 (&pb)[2][2], const int (&ka)[4], const bf16x8 (&qr)[2][4]) {
  bf16x8 f0[4], f1[4];
  QK16_RD(f0, 0);
#pragma unroll
  for (int kt = 0; kt < 4; ++kt) { s.t[kt][0] = (f32x4){0.f, 0.f, 0.f, 0.f}; s.t[kt][1] = (f32x4){0.f, 0.f, 0.f, 0.f}; }
  QK16_WAIT(f0); QK16_RD(f1, 1); QK16_MMA(f0, 0); if constexpr (FIN) fin16_part<0>(po, l, pb);
  QK16_WAIT(f1); QK16_RD(f0, 2); QK16_MMA(f1, 1); if constexpr (FIN) fin16_part<1>(po, l, pb);
  QK16_WAIT(f0); QK16_RD(f1, 3); QK16_MMA(f0, 2); if constexpr (FIN) fin16_part<2>(po, l, pb);
  QK16_WAIT(f1);                 QK16_MMA(f1, 3); if constexpr (FIN) fin16_part<3>(po, l, pb);
}
#undef QK16_MMA
#undef QK16_RD
#undef QK16_WAIT
template <int DT0> __device__ __forceinline__ void pv16_two(f32x4 (&o)[8][2], int vb, const bf16x8 (&pb)[2][2]) {
  const s16x4 a00 = tr_read<0 * 4096 + DT0 * 256>(vb), a01 = tr_read<1 * 4096 + DT0 * 256>(vb), a10 = tr_read<2 * 4096 + DT0 * 256>(vb), a11 = tr_read<3 * 4096 + DT0 * 256>(vb);
  const s16x4 b00 = tr_read<0 * 4096 + DT0 * 256 + 256>(vb), b01 = tr_read<1 * 4096 + DT0 * 256 + 256>(vb), b10 = tr_read<2 * 4096 + DT0 * 256 + 256>(vb), b11 = tr_read<3 * 4096 + DT0 * 256 + 256>(vb);
  asm volatile("s_waitcnt lgkmcnt(0)" ::: "memory"); SBAR();
#define PK(L, H) (bf16x8){L[0], L[1], L[2], L[3], H[0], H[1], H[2], H[3]}
  o[DT0][0] = __builtin_amdgcn_mfma_f32_16x16x32_bf16(PK(a00, a01), pb[0][0], o[DT0][0], 0, 0, 0);
  o[DT0][1] = __builtin_amdgcn_mfma_f32_16x16x32_bf16(PK(a00, a01), pb[1][0], o[DT0][1], 0, 0, 0);
  o[DT0 + 1][0] = __builtin_amdgcn_mfma_f32_16x16x32_bf16(PK(b00, b01), pb[0][0], o[DT0 + 1][0], 0, 0, 0);
  o[DT0 + 1][1] = __builtin_amdgcn_mfma_f32_16x16x32_bf16(PK(b00, b01), pb[1][0], o[DT0 + 1][1], 0, 0, 0);
  o[DT0][0] = __builtin_amdgcn_mfma_f32_16x16x32_bf16(PK(a10, a11), pb[0][1], o[DT0][0], 0, 0, 0);
  o[DT0][1] = __builtin_amdgcn_mfma_f32_16x16x32_bf16(PK(a10, a11), pb[1][1], o[DT0][1], 0, 0, 0);
  o[DT0 + 1][0] = __builtin_amdgcn_mfma_f32_16x16x32_bf16(PK(b10, b11), pb[0][1], o[DT0 + 1][0], 0, 0, 0);
  o[DT0 + 1][1] = __builtin_amdgcn_mfma_f32_16x16x32_bf16(PK(b10, b11), pb[1][1], o[DT0 + 1][1], 0, 0, 0);
#undef PK
}
__device__ __forceinline__ void pv16(f32x4 (&o)[8][2], int vb, const bf16x8 (&pb)[2][2]) { pv16_two<0>(o, vb, pb); pv16_two<2>(o, vb, pb); pv16_two<4>(o, vb, pb); pv16_two<6>(o, vb, pb); }
__device__ __forceinline__ float sum4groups(float v) {
  v += __builtin_bit_cast(float, __builtin_amdgcn_ds_swizzle(__builtin_bit_cast(int, v), 0x401F));
  auto rr = __builtin_amdgcn_permlane32_swap(__float_as_uint(v), __float_as_uint(v), false, false);
  return __uint_as_float(rr[0]) + __uint_as_float(rr[1]);
}
template <int NTT>
__device__ __forceinline__ void attn_unit16(const bf16* Qb, const bf16* Kh, const bf16* Vh, bf16* Ob, char* lds, PG8_LAS unsigned char* ldsl, const int tid,
                                            const float* gqp, const float* tab, const int t0, const float qmul) {
  static_assert(NTT % 4 == 0 && NTT >= 8, "ring loop: four-step body, three-step tail");
  int tl = tid; asm volatile("" : "+v"(tl));
  const int wid = tl >> 6, lane = tl & 63, li = lane & 15, lg = lane >> 4;
  char* const K_lds = lds;
  float l_reg[2] = {0.f, 0.f}; f32x4 o[8][2]; bf16x8 qr[2][4];
#pragma unroll
  for (int dt = 0; dt < 8; ++dt) { o[dt][0] = (f32x4){0.f, 0.f, 0.f, 0.f}; o[dt][1] = (f32x4){0.f, 0.f, 0.f, 0.f}; }
#pragma unroll
  for (int qt = 0; qt < 2; ++qt) { const bf16* Qw = Qb + (long)(wid * QBLK + 16 * qt + li) * LDQ + 8 * lg;
#pragma unroll
    for (int ks = 0; ks < 4; ++ks) qr[qt][ks] = *reinterpret_cast<const bf16x8*>(Qw + 32 * ks); }
#pragma unroll
  for (int qt = 0; qt < 2; ++qt) { float qf[4][8]; float ss = 0.f;
#pragma unroll
    for (int ks = 0; ks < 4; ++ks) { const u32x4 w = __builtin_bit_cast(u32x4, qr[qt][ks]);
      qf[ks][0] = __uint_as_float(w.x << 16); qf[ks][1] = __uint_as_float(w.x & 0xffff0000u); qf[ks][2] = __uint_as_float(w.y << 16); qf[ks][3] = __uint_as_float(w.y & 0xffff0000u);
      qf[ks][4] = __uint_as_float(w.z << 16); qf[ks][5] = __uint_as_float(w.z & 0xffff0000u); qf[ks][6] = __uint_as_float(w.w << 16); qf[ks][7] = __uint_as_float(w.w & 0xffff0000u);
#pragma unroll
      for (int j = 0; j < 8; ++j) ss += qf[ks][j] * qf[ks][j]; }
    ss = sum4groups(ss);
    const float rs = __builtin_amdgcn_rsqf(ss * (1.0f / 128) + 1e-6f) * qmul;
    const int t = t0 + wid * QBLK + 16 * qt + li;
#pragma unroll
    for (int ks = 0; ks < 4; ++ks) { const float* gp = gqp + 32 * ks + 8 * lg; const float4 g0 = *reinterpret_cast<const float4*>(gp), g1 = *reinterpret_cast<const float4*>(gp + 4);
      qf[ks][0] *= rs * g0.x; qf[ks][1] *= rs * g0.y; qf[ks][2] *= rs * g0.z; qf[ks][3] *= rs * g0.w; qf[ks][4] *= rs * g1.x; qf[ks][5] *= rs * g1.y; qf[ks][6] *= rs * g1.z; qf[ks][7] *= rs * g1.w; }
#pragma unroll
    for (int ax = 0; ax < 2; ++ax) { const int pos = ax ? (t & 63) : (t >> 6); const int da = 2 * ax, db = da + 1;
      const float4* tp = reinterpret_cast<const float4*>(tab + (size_t)(pos * 32 + 8 * lg) * 2);
#pragma unroll
      for (int j2 = 0; j2 < 4; ++j2) { const float4 cs = tp[j2];
        { const float x1 = qf[da][2 * j2], x2 = qf[db][2 * j2]; qf[da][2 * j2] = x1 * cs.x - x2 * cs.y; qf[db][2 * j2] = x2 * cs.x + x1 * cs.y; }
        { const float x1 = qf[da][2 * j2 + 1], x2 = qf[db][2 * j2 + 1]; qf[da][2 * j2 + 1] = x1 * cs.z - x2 * cs.w; qf[db][2 * j2 + 1] = x2 * cs.z + x1 * cs.w; } } }
#pragma unroll
    for (int ks = 0; ks < 4; ++ks) { u32x4 w = {cvtpk(qf[ks][0], qf[ks][1]), cvtpk(qf[ks][2], qf[ks][3]), cvtpk(qf[ks][4], qf[ks][5]), cvtpk(qf[ks][6], qf[ks][7])}; qr[qt][ks] = __builtin_bit_cast(bf16x8, w); } }
  int ka[4];
#pragma unroll
  for (int ks = 0; ks < 4; ++ks) ka[ks] = (int)(uintptr_t)K_lds + li * 256 + ((64 * ks + 16 * lg) ^ (16 * li));
  constexpr int NBUF = 4;
  const int vb0 = (int)(uintptr_t)(lds + NBUF * SHM_K) + (lg >> 1) * 2048 + (4 * (lg & 1) + ((lane >> 2) & 3)) * 32 + 8 * (lane & 3);
  S16 pA, pB; bf16x8 pb[2][2];
  const int widu = __builtin_amdgcn_readfirstlane(wid);
  const int krow = 4 * widu + (lane >> 4), vrow = 8 * (widu >> 1) + ((lane >> 1) & 7), vd = 16 * ((4 * widu + (lane >> 4)) & 7) + 8 * (lane & 1);
  const unsigned koff = (unsigned)(krow * LDK + (((lane & 15) ^ (krow & 15)) << 3)) * 2u;
  const unsigned voff = (unsigned)(vrow * LDK + vd + (int)(Vh - Kh)) * 2u;
  PG8_LAS unsigned char* const dK = ldsl + widu * 1024; PG8_LAS unsigned char* const dV = ldsl + NBUF * SHM_K + widu * 1024;
#define RDMAK(b, k0) do { const char* g_ = (const char*)(Kh + (long)(k0) * LDK); \
    __builtin_amdgcn_global_load_lds((const unsigned*)(g_ + koff), (PG8_LAS unsigned*)(dK + (b) * SHM_K), 16, 0, 0); \
    __builtin_amdgcn_global_load_lds((const unsigned*)(g_ + 64L * LDK + koff), (PG8_LAS unsigned*)(dK + (b) * SHM_K + 8192), 16, 0, 0); } while (0)
#define RDMAV(b, k0) do { const char* g_ = (const char*)(Kh + (long)(k0) * LDK); \
    __builtin_amdgcn_global_load_lds((const unsigned*)(g_ + voff), (PG8_LAS unsigned*)(dV + (b) * SHM_V), 16, 0, 0); \
    __builtin_amdgcn_global_load_lds((const unsigned*)(g_ + 64L * LDK + voff), (PG8_LAS unsigned*)(dV + (b) * SHM_V + 8192), 16, 0, 0); } while (0)
#define PBAR() do { asm volatile("" ::: "memory"); __builtin_amdgcn_s_barrier(); asm volatile("" ::: "memory"); } while (0)
#define XWAIT(n) do { if ((n) == 4) asm volatile("s_waitcnt vmcnt(4)" ::: "memory"); else if ((n) == 2) asm volatile("s_waitcnt vmcnt(2)" ::: "memory"); else asm volatile("s_waitcnt vmcnt(0)" ::: "memory"); PBAR(); } while (0)
#define RSTEP(PN, PO, KC, WK, WV, T) do { \
    if (WK) RDMAK(((KC) + 2) & 3, ((T) + 2) * KVBLK); if (WV) RDMAV(((KC) + 1) & 3, ((T) + 1) * KVBLK); \
    SBAR(); qk16<KC, true>(PN, PO, l_reg, pb, ka, qr); SBAR(); \
    XWAIT(((WK) ? 2 : 0) + ((WV) ? 2 : 0)); \
    pv16(o, vb0 + (((KC) + 3) & 3) * (int)SHM_V, pb); \
    PBAR(); } while (0)
  __syncthreads();
  RDMAK(0, 0); RDMAK(1, KVBLK); RDMAV(0, 0); XWAIT(0);
  asm volatile("s_cmp_lt_i32 %0, 4\n\ts_cbranch_scc1 .Lpp_a%=\n\ts_barrier\n.Lpp_a%=:" :: "s"(widu) : "scc", "memory");
  RDMAK(2, 2 * KVBLK); RDMAV(1, KVBLK); SBAR(); qk16<0, false>(pA, pB, l_reg, pb, ka, qr); SBAR(); XWAIT(4);
  PBAR();
  for (int t = 1; t < NTT - 3; t += 4) {
    RSTEP(pB, pA, 1, true, true, t);
    RSTEP(pA, pB, 2, true, true, t + 1);
    RSTEP(pB, pA, 3, true, true, t + 2);
    RSTEP(pA, pB, 0, true, true, t + 3);
  }
  RSTEP(pB, pA, 1, true, true, NTT - 3);
  RSTEP(pA, pB, 2, false, true, NTT - 2);
  RSTEP(pB, pA, 3, false, false, NTT - 1);
  finish16(pB, l_reg, pb); SBAR();
  pv16(o, vb0 + 3 * (int)SHM_V, pb);
  asm volatile("s_cmp_ge_i32 %0, 4\n\ts_cbranch_scc1 .Lpp_b%=\n\ts_barrier\n.Lpp_b%=:" :: "s"(widu) : "scc", "memory");
#undef RDMAK
#undef RDMAV
#undef PBAR
#undef XWAIT
#undef RSTEP
  const float rl0 = __builtin_amdgcn_rcpf(sum4groups(l_reg[0])), rl1 = __builtin_amdgcn_rcpf(sum4groups(l_reg[1]));
  bf16* Ow = Ob + (long)(wid * QBLK + li) * LDO + 4 * lg;
  asm volatile("" : "+v"(Ow));
#pragma unroll
  for (int dt = 0; dt < 8; ++dt)
#pragma unroll
    for (int qt = 0; qt < 2; ++qt) { const f32x4 v = o[dt][qt] * (qt ? rl1 : rl0);
      uint2 w; w.x = cvtpk(v[0], v[1]); w.y = cvtpk(v[2], v[3]);
      *reinterpret_cast<uint2*>(Ow + (long)(16 * qt) * LDO + 16 * dt) = w; }
}
}

constexpr int NWAVES = 8;
constexpr int DM = 2048, DFF = 5632, NGU = 2 * DFF, INW = 3584, ATTW = 1024, RNNW = 1024;
constexpr int MH = 32768;
constexpr int ZQ = 0, ZK = 1024, ZV = 1280, ZXR = 1536, ZYR = 2560;
constexpr float EPS = 1e-6f;
constexpr int LC = 256;
constexpr int NCHUNK = MH / LC;
constexpr size_t MiB = 1u << 20;
constexpr size_t WS_CTL = 0, CTL_ZERO_BYTES = 1 * MiB;
constexpr size_t WS_ROPE = 1 * MiB;
constexpr size_t WS_SUM = 2 * MiB;
constexpr size_t WS_CIN = 4 * MiB;
constexpr size_t WS_RS = 5 * MiB;
constexpr size_t WS_WGU1 = 8 * MiB, WS_WD1 = 52 * MiB, WS_WIN = 74 * MiB, WS_WOUT = 88 * MiB, WS_WGU2 = 96 * MiB, WS_WD2 = 140 * MiB;
constexpr size_t WS_XN = 162 * MiB;
constexpr size_t WS_Y = 290 * MiB;
constexpr size_t WS_H = 418 * MiB;
constexpr size_t WS_Z = WS_H, WS_HLB = WS_H + 224 * MiB, WS_PRB = WS_H + 288 * MiB;
constexpr size_t WS_HLF = WS_Y, WS_PRF = WS_Y + 64 * MiB;
constexpr size_t WS_MIX = 770 * MiB;
constexpr size_t WS_END = 898 * MiB;
static_assert(WS_WGU1 + (size_t)NGU * DM * 2 <= WS_WD1 && WS_WD1 + (size_t)DM * DFF * 2 <= WS_WIN && WS_WIN + (size_t)INW * DM * 2 <= WS_WOUT && WS_WOUT + (size_t)DM * DM * 2 <= WS_WGU2 &&
              WS_WGU2 + (size_t)NGU * DM * 2 <= WS_WD2 && WS_WD2 + (size_t)DM * DFF * 2 <= WS_XN && WS_XN + (size_t)MH * DM * 2 <= WS_Y && WS_Y + (size_t)MH * DM * 2 <= WS_H &&
              WS_H + (size_t)MH * DFF * 2 <= WS_MIX && WS_MIX + (size_t)MH * DM * 2 <= WS_END && WS_Z + (size_t)MH * INW * 2 <= WS_HLB && WS_PRB + (size_t)MH * RNNW * 2 <= WS_MIX && WS_PRF + (size_t)MH * RNNW * 2 <= WS_H, "d_ws map");
constexpr int CW_TMO = 0, CW_CODE = 1;
constexpr int CW_BAR = 4096;
constexpr int RING_OFF = 0, RING_BYTES = 131072;
constexpr int LDSCTL_OFF = RING_BYTES, MISC_OFF = LDSCTL_OFF + 320;
constexpr int LDS_BYTES = 147456;
static_assert(MISC_OFF + 128 <= LDS_BYTES, "LDS map");

#define GAS __attribute__((address_space(1)))
#define LAS __attribute__((address_space(3)))
typedef unsigned short bf16;
typedef unsigned v4u __attribute__((ext_vector_type(4)));
typedef unsigned v2u __attribute__((ext_vector_type(2)));
typedef float f32x4 __attribute__((ext_vector_type(4)));
typedef float f32x2 __attribute__((ext_vector_type(2)));
typedef float f32x16 __attribute__((ext_vector_type(16)));
typedef short bf16x8 __attribute__((ext_vector_type(8)));
typedef GAS unsigned gu32;
#define RLX_AGENT __ATOMIC_RELAXED, __HIP_MEMORY_SCOPE_AGENT
#define LDS_WAIT() asm volatile("s_waitcnt lgkmcnt(0)" ::: "memory")
#define VM_WAIT() asm volatile("s_waitcnt vmcnt(0)" ::: "memory")
__device__ __forceinline__ unsigned pk2(float lo, float hi) { unsigned r; asm volatile("v_cvt_pk_bf16_f32 %0, %1, %2" : "=v"(r) : "v"(lo), "v"(hi)); return r; }
__device__ __forceinline__ float bflo(unsigned w) { return __uint_as_float(w << 16); }
__device__ __forceinline__ float bfhi(unsigned w) { return __uint_as_float(w & 0xffff0000u); }

#define XB_TMO      128
#define XB_XCNT(j)  (256  + 64 * (j))
#define XB_XSUB(j)  (1280 + 64 * (j))
#define XB_XGEN(j)  (2304 + 64 * (j))
#define XB_TOP      3328
#define XB_TOPGEN   3392
#define XCD_BAR_WORDS 3456
#define XB_SPIN_CAP (1u << 18)
__device__ __forceinline__ unsigned xb_ld(unsigned* p)              { return __hip_atomic_load(p, __ATOMIC_RELAXED, __HIP_MEMORY_SCOPE_AGENT); }
__device__ __forceinline__ unsigned xb_add(unsigned* p, unsigned v) { return __hip_atomic_fetch_add(p, v, __ATOMIC_RELAXED, __HIP_MEMORY_SCOPE_AGENT); }
__device__ __forceinline__ unsigned xb_xcc_id() { return (unsigned)__builtin_amdgcn_s_getreg((3 << 11) | 20) & 0xFu; }
#define XB_SPIN(cond, bar) do { unsigned _sp = 0; while (cond) { __builtin_amdgcn_s_sleep(1); \
    if ((++_sp & 255u) == 0u) { if (xb_ld(&(bar)[XB_TMO])) break; if (_sp > XB_SPIN_CAP) { atomicAdd(&(bar)[XB_TMO], 1u); break; } } } } while (0)
__device__ __forceinline__ int lane_id() { return (int)__builtin_amdgcn_mbcnt_hi(~0u, __builtin_amdgcn_mbcnt_lo(~0u, 0u)); }
struct XcdBarrier { unsigned* bar; unsigned x; volatile LAS unsigned* st; int wv; };
__device__ __forceinline__ XcdBarrier xcd_barrier_post(unsigned* bar, volatile LAS unsigned* st, int wv) {
    XcdBarrier b; b.bar = bar; b.x = xb_xcc_id(); b.st = st; b.wv = wv;
    if (wv == 0 && lane_id() == 0) (void)xb_add(&bar[XB_XCNT(b.x)], 1u);
    return b;
}
__device__ __forceinline__ void xcd_barrier_complete(unsigned* bar, unsigned x, unsigned& nloc, unsigned& nx) {
    const unsigned G = gridDim.x * gridDim.y * gridDim.z;
    unsigned sum, cnt, mine, sp = 0u;
    for (;;) {
        sum = 0u; cnt = 0u; mine = 0u;
#pragma unroll
        for (unsigned j = 0; j < 16; ++j) { const unsigned c = xb_ld(&bar[XB_XCNT(j)]); sum += c; cnt += (c > 0u) ? 1u : 0u; mine = (j == x) ? c : mine; }
        if (sum == G) break;
        __builtin_amdgcn_s_sleep(1);
        if ((++sp & 255u) == 0u) { if (xb_ld(&bar[XB_TMO])) break; if (sp > XB_SPIN_CAP) { atomicAdd(&bar[XB_TMO], 1u); break; } }
    }
    nloc = mine > 0u ? mine : 1u; nx = cnt > 0u ? cnt : 1u;
}
__device__ __forceinline__ void xcd_barrier(const XcdBarrier& b) {
    asm volatile("s_waitcnt vmcnt(0)" ::: "memory");
    __syncthreads();
    if (b.wv == 0 && lane_id() == 0) {
        unsigned* bar = b.bar;
        __builtin_amdgcn_s_waitcnt(0);
        unsigned nloc = b.st[0], nx = b.st[1];
        if (nloc == 0u) { xcd_barrier_complete(bar, b.x, nloc, nx); b.st[0] = nloc; b.st[1] = nx; }
        const unsigned old = xb_add(&bar[XB_XSUB(b.x)], 1u);
        const unsigned gen = old / nloc;
        if (old + 1u == (gen + 1u) * nloc) {
            __builtin_amdgcn_fence(__ATOMIC_RELEASE, "agent");
            asm volatile("s_waitcnt vmcnt(0)" ::: "memory");
            const unsigned og = xb_add(&bar[XB_TOP], 1u);
            const unsigned tg = og / nx;
            if (og + 1u == (tg + 1u) * nx) xb_add(&bar[XB_TOPGEN], 1u);
            else XB_SPIN(xb_ld(&bar[XB_TOPGEN]) == tg, bar);
            __builtin_amdgcn_fence(__ATOMIC_ACQUIRE, "agent");
            xb_add(&bar[XB_XGEN(b.x)], 1u);
            asm volatile("s_waitcnt vmcnt(0)" ::: "memory");
        } else {
            XB_SPIN(xb_ld(&bar[XB_XGEN(b.x)]) == gen, bar);
            __builtin_amdgcn_fence(__ATOMIC_ACQUIRE, "agent");
            asm volatile("s_waitcnt vmcnt(0)" ::: "memory");
        }
    }
    __syncthreads();
}

struct Args { unsigned long long in[32]; unsigned long long out, ws; int ph_lo, ph_hi; };
typedef const __attribute__((address_space(4))) Args* ArgP;
__device__ __forceinline__ ArgP argp() { ArgP p = (ArgP)__builtin_amdgcn_kernarg_segment_ptr(); asm volatile("" : "+s"(p)); return p; }
__device__ __forceinline__ const float* inp(ArgP A, int k) { return (const float*)(const GAS float*)A->in[k]; }
__device__ __forceinline__ float* outp(ArgP A) { return (float*)(GAS float*)A->out; }
template <class T> __device__ __forceinline__ T* wsp(ArgP A, size_t off) { return (T*)(GAS T*)(A->ws + off); }
struct Frame {
    LAS unsigned char* lds;
    int tid, lane, wave;
    int bid, G;
    int gw, NGW;
};
template <int TAG = 0> __device__ __forceinline__ Frame mkframe(unsigned char* lds, int wv) {
    Frame F; F.lds = (LAS unsigned char*)lds;
    int t; asm volatile("v_mbcnt_lo_u32_b32 %0, -1, 0\n\tv_mbcnt_hi_u32_b32 %0, -1, %0\n\tv_lshl_add_u32 %0, %1, 6, %0 ; frame %2" : "=&v"(t) : "s"(wv), "i"(TAG));
    int b = blockIdx.x; asm volatile("; frame %1" : "+s"(b) : "i"(TAG)); int g = gridDim.x; asm volatile("; frame %1" : "+s"(g) : "i"(TAG));
    F.tid = t; F.lane = t & 63; F.wave = __builtin_amdgcn_readfirstlane(t >> 6); F.bid = b; F.G = g; F.gw = b * NWAVES + F.wave; F.NGW = g * NWAVES;
    return F;
}
__device__ __forceinline__ float wave_sum(float v) {
    v += __builtin_bit_cast(float, __builtin_amdgcn_update_dpp(0, __builtin_bit_cast(int, v), 0xB1, 0xF, 0xF, true));
    v += __builtin_bit_cast(float, __builtin_amdgcn_update_dpp(0, __builtin_bit_cast(int, v), 0x4E, 0xF, 0xF, true));
    v += __builtin_bit_cast(float, __builtin_amdgcn_update_dpp(0, __builtin_bit_cast(int, v), 0x141, 0xF, 0xF, true));
    v += __builtin_bit_cast(float, __builtin_amdgcn_update_dpp(0, __builtin_bit_cast(int, v), 0x140, 0xF, 0xF, true));
    const int iv = __builtin_bit_cast(int, v);
    return (__builtin_bit_cast(float, __builtin_amdgcn_readlane(iv, 0)) + __builtin_bit_cast(float, __builtin_amdgcn_readlane(iv, 16))) +
           (__builtin_bit_cast(float, __builtin_amdgcn_readlane(iv, 32)) + __builtin_bit_cast(float, __builtin_amdgcn_readlane(iv, 48)));
}
__device__ __forceinline__ float wave_max(float v) {
    v = fmaxf(v, __builtin_bit_cast(float, __builtin_amdgcn_update_dpp(0, __builtin_bit_cast(int, v), 0xB1, 0xF, 0xF, true)));
    v = fmaxf(v, __builtin_bit_cast(float, __builtin_amdgcn_update_dpp(0, __builtin_bit_cast(int, v), 0x4E, 0xF, 0xF, true)));
    v = fmaxf(v, __builtin_bit_cast(float, __builtin_amdgcn_update_dpp(0, __builtin_bit_cast(int, v), 0x141, 0xF, 0xF, true)));
    v = fmaxf(v, __builtin_bit_cast(float, __builtin_amdgcn_update_dpp(0, __builtin_bit_cast(int, v), 0x140, 0xF, 0xF, true)));
    const int iv = __builtin_bit_cast(int, v);
    return fmaxf(fmaxf(__builtin_bit_cast(float, __builtin_amdgcn_readlane(iv, 0)), __builtin_bit_cast(float, __builtin_amdgcn_readlane(iv, 16))),
                 fmaxf(__builtin_bit_cast(float, __builtin_amdgcn_readlane(iv, 32)), __builtin_bit_cast(float, __builtin_amdgcn_readlane(iv, 48))));
}
__device__ __forceinline__ float dpp_xor1(float v) { return __builtin_bit_cast(float, __builtin_amdgcn_update_dpp(0, __builtin_bit_cast(int, v), 0xB1, 0xF, 0xF, true)); }
__device__ __forceinline__ float dpp_xor2(float v) { return __builtin_bit_cast(float, __builtin_amdgcn_update_dpp(0, __builtin_bit_cast(int, v), 0x4E, 0xF, 0xF, true)); }
__device__ __forceinline__ float dpp_hmirror(float v) { return __builtin_bit_cast(float, __builtin_amdgcn_update_dpp(0, __builtin_bit_cast(int, v), 0x141, 0xF, 0xF, true)); }
__device__ __forceinline__ float vsel(bool c, float a, float b) { asm volatile("" : "+v"(a), "+v"(b)); return c ? a : b; }
__device__ __forceinline__ float xor32(float v, int hi) { auto rr = __builtin_amdgcn_permlane32_swap(__float_as_uint(v), __float_as_uint(v), false, false); return __uint_as_float(hi ? rr[0] : rr[1]); }

__device__ __forceinline__ void transpose_item(const float* W, int K, int N, bf16* dst0, int k0, int n0, LAS float* scr, int lane, const float* gk) {
    f32x4 v[8];
#pragma unroll
    for (int i = 0; i < 8; ++i) { const int kk = 8 * i + (lane >> 3); v[i] = __builtin_nontemporal_load((const f32x4*)(W + (size_t)(k0 + kk) * N + n0 + 4 * (lane & 7))); }
#pragma unroll
    for (int i = 0; i < 8; ++i) { const int kk = 8 * i + (lane >> 3); const float g = gk ? gk[k0 + kk] : 1.0f; LAS float* s = scr + kk * 33 + 4 * (lane & 7);
        s[0] = v[i].x * g; s[1] = v[i].y * g; s[2] = v[i].z * g; s[3] = v[i].w * g; }
    LDS_WAIT(); asm volatile("" ::: "memory");
    const int c = lane & 7;
#pragma unroll
    for (int j = 0; j < 4; ++j) { const int n = (lane >> 3) + 8 * j; const LAS float* s = scr + (8 * c) * 33 + n;
        v4u o; o.x = pk2(s[0 * 33], s[1 * 33]); o.y = pk2(s[2 * 33], s[3 * 33]); o.z = pk2(s[4 * 33], s[5 * 33]); o.w = pk2(s[6 * 33], s[7 * 33]);
        *(v4u*)(dst0 + (size_t)n * K + k0 + 8 * c) = o; }
    LDS_WAIT(); asm volatile("" ::: "memory");
}
__device__ __forceinline__ void conv_item(const float* W, int K, int N, bf16* WT, int mode, int item, LAS float* scr, int lane, const float* gk = nullptr) {
    const int nblk = N / 32, kb = item / nblk, nb = item % nblk, k0 = 64 * kb, n0 = 32 * nb;
    const int drow = mode == 0 ? n0 : (256 * (n0 >> 7) + (n0 & 127) + (mode == 2 ? 128 : 0));
    transpose_item(W, K, N, WT + (size_t)drow * K, k0, n0, scr, lane, gk);
}

__device__ __forceinline__ float sumsq8(const f32x4 (&x)[8]) { float ss = 0.f;
#pragma unroll
    for (int j = 0; j < 8; ++j) ss += (x[j].x * x[j].x + x[j].y * x[j].y) + (x[j].z * x[j].z + x[j].w * x[j].w);
    return ss; }
__device__ __forceinline__ void load_bf_row(const bf16* p, int lane, f32x4 (&x)[8]) { const v2u* r = (const v2u*)p + lane; v2u b[8];
#pragma unroll
    for (int j = 0; j < 8; ++j) b[j] = r[64 * j];
#pragma unroll
    for (int j = 0; j < 8; ++j) x[j] = (f32x4){bflo(b[j].x), bfhi(b[j].x), bflo(b[j].y), bfhi(b[j].y)}; }
__device__ __forceinline__ void store_xb_rs(const f32x4 (&x)[8], bf16* XBrow, float* RSrow, int lane) {
    const float r = __builtin_amdgcn_rsqf(wave_sum(sumsq8(x)) * (1.0f / DM) + EPS);
    v2u* o = (v2u*)XBrow + lane;
#pragma unroll
    for (int j = 0; j < 8; ++j) { v2u w; w.x = pk2(x[j].x, x[j].y); w.y = pk2(x[j].z, x[j].w); o[64 * j] = w; }
    if (lane == 0) *RSrow = r;
}
__device__ __forceinline__ void pre_rows(const Frame& F, const float* xin, bf16* XB, float* RS, int nrows) {
    int row = F.gw; f32x4 cur[8], nxt[8];
    if (row < nrows) { const f32x4* xr = (const f32x4*)(xin + (size_t)row * DM) + F.lane;
#pragma unroll
        for (int j = 0; j < 8; ++j) cur[j] = __builtin_nontemporal_load(xr + 64 * j); }
    while (row < nrows) {
        const int nrow = row + F.NGW;
        { const f32x4* xr = (const f32x4*)(xin + (size_t)(nrow < nrows ? nrow : row) * DM) + F.lane;
#pragma unroll
            for (int j = 0; j < 8; ++j) nxt[j] = __builtin_nontemporal_load(xr + 64 * j); }
        store_xb_rs(cur, XB + (size_t)row * DM, RS + row, F.lane);
#pragma unroll
        for (int j = 0; j < 8; ++j) cur[j] = nxt[j];
        row = nrow;
    }
}
template <bool XIN_F32, bool NEXT> struct RowRaw { f32x4 x32[XIN_F32 ? 8 : 1]; v2u xb[XIN_F32 ? 1 : 8]; v2u y[8]; f32x4 n32[NEXT ? 8 : 1]; };
template <bool XIN_F32, bool NEXT>
__device__ __forceinline__ void row_load(RowRaw<XIN_F32, NEXT>& R, const float* xin32, const bf16* XB, const bf16* Y, const float* xnext, int row, int lane) {
    if (XIN_F32) { const f32x4* xr = (const f32x4*)(xin32 + (size_t)row * DM) + lane;
#pragma unroll
        for (int j = 0; j < 8; ++j) R.x32[j] = xr[64 * j]; }
    else { const v2u* xr = (const v2u*)(XB + (size_t)row * DM) + lane;
#pragma unroll
        for (int j = 0; j < 8; ++j) R.xb[j] = xr[64 * j]; }
    { const v2u* yr = (const v2u*)(Y + (size_t)row * DM) + lane;
#pragma unroll
        for (int j = 0; j < 8; ++j) R.y[j] = __builtin_nontemporal_load(yr + 64 * j); }
    if (NEXT) { const f32x4* xr = (const f32x4*)(xnext + (size_t)row * DM) + lane;
#pragma unroll
        for (int j = 0; j < 8; ++j) R.n32[j] = __builtin_nontemporal_load(xr + 64 * j); }
}
template <bool XIN_F32, bool FINAL, bool NEXT>
__device__ __forceinline__ void t_rows(const Frame& F, const float* xin32, const bf16* Y, float coef, const float* gpost, float* out32, bf16* XB, float* RS, const float* xnext, int nrows) {
    f32x4 gp[8];
#pragma unroll
    for (int j = 0; j < 8; ++j) gp[j] = ((const f32x4*)gpost)[64 * j + F.lane];
    int row = F.gw; RowRaw<XIN_F32, NEXT> cur, nxt;
    if (row < nrows) row_load<XIN_F32, NEXT>(cur, xin32, XB, Y, xnext, row, F.lane);
    while (row < nrows) {
        const int nrow = row + F.NGW;
        row_load<XIN_F32, NEXT>(nxt, xin32, XB, Y, xnext, nrow < nrows ? nrow : row, F.lane);
        f32x4 x[8], y[8];
#pragma unroll
        for (int j = 0; j < 8; ++j) { x[j] = XIN_F32 ? cur.x32[j] : (f32x4){bflo(cur.xb[j].x), bfhi(cur.xb[j].x), bflo(cur.xb[j].y), bfhi(cur.xb[j].y)};
            y[j] = (f32x4){bflo(cur.y[j].x), bfhi(cur.y[j].x), bflo(cur.y[j].y), bfhi(cur.y[j].y)}; }
        const float r = coef * __builtin_amdgcn_rsqf(wave_sum(sumsq8(y)) * (1.0f / DM) + EPS);
#pragma unroll
        for (int j = 0; j < 8; ++j) x[j] = x[j] + (y[j] * gp[j]) * r;
        if (FINAL) { f32x4* xo = (f32x4*)(out32 + (size_t)row * DM) + F.lane;
#pragma unroll
            for (int j = 0; j < 8; ++j) __builtin_nontemporal_store(x[j], xo + 64 * j);
            if (NEXT) { f32x4 xn[8];
#pragma unroll
                for (int j = 0; j < 8; ++j) xn[j] = cur.n32[j];
                store_xb_rs(xn, XB + (size_t)row * DM, RS + row, F.lane); } }
        else store_xb_rs(x, XB + (size_t)row * DM, RS + row, F.lane);
        cur = nxt; row = nrow;
    }
}
__device__ __forceinline__ void unpack8(const v4u w, float (&f)[8]) { f[0] = bflo(w.x); f[1] = bfhi(w.x); f[2] = bflo(w.y); f[3] = bfhi(w.y); f[4] = bflo(w.z); f[5] = bfhi(w.z); f[6] = bflo(w.w); f[7] = bfhi(w.w); }
__device__ __forceinline__ float gelu_tanh(float x) { const float z = 1.5957691216057308f * (x + 0.044715f * x * x * x); return x * __builtin_amdgcn_rcpf(1.0f + __builtin_amdgcn_exp2f(-1.4426950408889634f * z)); }
struct MixRaw { v4u o[2], y[2], hf[2], pf[2], hb[2], pb[2]; };
__device__ __forceinline__ void mix_load(MixRaw& R, const bf16* Z, const bf16* HLF, const bf16* PRF, const bf16* HLB, const bf16* PRB, int row, int lane) {
    const bf16* zr = Z + (size_t)row * INW; const size_t ro = (size_t)row * RNNW;
#pragma unroll
    for (int j = 0; j < 2; ++j) { const int c = 512 * j + 8 * lane; R.o[j] = __builtin_nontemporal_load((const v4u*)(zr + ZQ + c)); R.y[j] = __builtin_nontemporal_load((const v4u*)(zr + ZYR + c));
        R.hf[j] = __builtin_nontemporal_load((const v4u*)(HLF + ro + c)); R.pf[j] = __builtin_nontemporal_load((const v4u*)(PRF + ro + c)); R.hb[j] = __builtin_nontemporal_load((const v4u*)(HLB + ro + c)); R.pb[j] = __builtin_nontemporal_load((const v4u*)(PRB + ro + c)); }
}
__device__ __forceinline__ void mix_rows(const Frame& F, const bf16* Z, const bf16* HLF, const bf16* PRF, const bf16* HLB, const bf16* PRB, const float* CIN, const float* ga, const float* gr, bf16* MIX) {
    f32x4 gA[2][2], gR[2][2];
#pragma unroll
    for (int j = 0; j < 2; ++j)
#pragma unroll
        for (int q = 0; q < 2; ++q) { gA[j][q] = *(const f32x4*)(ga + 512 * j + 8 * F.lane + 4 * q); gR[j][q] = *(const f32x4*)(gr + 512 * j + 8 * F.lane + 4 * q); }
    int row = F.gw; MixRaw cur, nxt;
    if (row < MH) mix_load(cur, Z, HLF, PRF, HLB, PRB, row, F.lane);
    while (row < MH) {
        const int nrow = row + F.NGW;
        mix_load(nxt, Z, HLF, PRF, HLB, PRB, nrow < MH ? nrow : row, F.lane);
        const float* cf = CIN + (size_t)(row / LC) * 2 * RNNW; const float* cb = cf + RNNW;
        float o[2][8], rn[2][8]; float sa = 0.f, sr = 0.f;
#pragma unroll
        for (int j = 0; j < 2; ++j) { float y[8], hf[8], pf[8], hb[8], pb[8]; unpack8(cur.o[j], o[j]); unpack8(cur.y[j], y); unpack8(cur.hf[j], hf); unpack8(cur.pf[j], pf); unpack8(cur.hb[j], hb); unpack8(cur.pb[j], pb);
            const int c = 512 * j + 8 * F.lane; const f32x4 f0 = *(const f32x4*)(cf + c), f1 = *(const f32x4*)(cf + c + 4), b0 = *(const f32x4*)(cb + c), b1 = *(const f32x4*)(cb + c + 4);
            const float cfv[8] = {f0.x, f0.y, f0.z, f0.w, f1.x, f1.y, f1.z, f1.w}, cbv[8] = {b0.x, b0.y, b0.z, b0.w, b1.x, b1.y, b1.z, b1.w};
#pragma unroll
            for (int e = 0; e < 8; ++e) { sa += o[j][e] * o[j][e]; const float h = (hf[e] + pf[e] * cfv[e]) + (hb[e] + pb[e] * cbv[e]); rn[j][e] = h * gelu_tanh(y[e]); sr += rn[j][e] * rn[j][e]; } }
        const float ra = __builtin_amdgcn_rsqf(wave_sum(sa) * (1.0f / ATTW) + EPS), rr = __builtin_amdgcn_rsqf(wave_sum(sr) * (1.0f / RNNW) + EPS);
        bf16* mo = MIX + (size_t)row * DM;
#pragma unroll
        for (int j = 0; j < 2; ++j) {
            v4u w; w.x = pk2(o[j][0] * ra * gA[j][0].x, o[j][1] * ra * gA[j][0].y); w.y = pk2(o[j][2] * ra * gA[j][0].z, o[j][3] * ra * gA[j][0].w);
            w.z = pk2(o[j][4] * ra * gA[j][1].x, o[j][5] * ra * gA[j][1].y); w.w = pk2(o[j][6] * ra * gA[j][1].z, o[j][7] * ra * gA[j][1].w);
            *(v4u*)(mo + 512 * j + 8 * F.lane) = w;
            v4u v; v.x = pk2(rn[j][0] * rr * gR[j][0].x, rn[j][1] * rr * gR[j][0].y); v.y = pk2(rn[j][2] * rr * gR[j][0].z, rn[j][3] * rr * gR[j][0].w);
            v.z = pk2(rn[j][4] * rr * gR[j][1].x, rn[j][5] * rr * gR[j][1].y); v.w = pk2(rn[j][6] * rr * gR[j][1].z, rn[j][7] * rr * gR[j][1].w);
            *(v4u*)(mo + ATTW + 512 * j + 8 * F.lane) = v;
        }
        cur = nxt; row = nrow;
    }
}

__device__ __forceinline__ void rope_table(const Frame& F, float* tab) {
    const int gid = F.bid * (NWAVES * 64) + F.tid;
    if (gid < 256 * 32) {
        const int pos = gid >> 5, p = gid & 31;
        double f = 1.0; for (int i = 0; i < p; ++i) f *= 0.7498942093324558;
        const float inv = (float)f; const float ang = (float)pos * inv;
        const double a = (double)ang; const double kq = __builtin_rint(a * 0.6366197723675814); const double r = a - kq * 1.5707963267948966, r2 = r * r;
        const double s = r * (1.0 + r2 * (-1.0 / 6 + r2 * (1.0 / 120 + r2 * (-1.0 / 5040 + r2 * (1.0 / 362880 + r2 * (-1.0 / 39916800 + r2 * (1.0 / 6227020800.0)))))));
        const double c = 1.0 + r2 * (-0.5 + r2 * (1.0 / 24 + r2 * (-1.0 / 720 + r2 * (1.0 / 40320 + r2 * (-1.0 / 3628800 + r2 * (1.0 / 479001600.0))))));
        const int q = ((int)kq) & 3;
        const double cs = q == 0 ? c : (q == 1 ? -s : (q == 2 ? -c : s)), sn = q == 0 ? s : (q == 1 ? c : (q == 2 ? -s : -c));
        tab[2 * gid] = (float)cs; tab[2 * gid + 1] = (float)sn;
    }
}
__device__ __forceinline__ float attn_bound(const float* gqp, const float* gkp, int lane) {
    float mq = fmaxf(fabsf(gqp[lane]), fabsf(gqp[lane + 64])), mk = fmaxf(fabsf(gkp[lane]), fabsf(gkp[lane + 64]));
    mq = wave_max(mq); mk = wave_max(mk);
    return __builtin_bit_cast(float, __builtin_amdgcn_readfirstlane(__builtin_bit_cast(int, 128.0f * mq * mk * att::SCALE)));
}
constexpr float ATT_FIX_MAX = 30.0f;
__device__ __forceinline__ bf16* rope_ptr(bf16* Z, int job, int lane) {
    const int i8 = lane & 7; const bool isq = job < MH;
    const int row = isq ? job : 4 * (job - MH) + (lane >> 4);
    const int col = isq ? (ZQ + (lane >> 3) * 128 + i8 * 16) : (ZK + ((lane >> 3) & 1) * 128 + i8 * 16);
    return Z + (size_t)row * INW + col;
}
__device__ __forceinline__ void rope_rows(const Frame& F, bf16* Z, const float* gqp, const float* gkp, const float* tab, int S) {
    const int i8 = F.lane & 7;
    const float qmul = attn_bound(gqp, gkp, F.lane) <= ATT_FIX_MAX ? att::SCALE * 1.4426950408889634f : 1.0f;
    float gq[16], gk[16];
#pragma unroll
    for (int e = 0; e < 16; ++e) { gq[e] = gqp[16 * i8 + e]; gk[e] = gkp[16 * i8 + e]; }
    const int axis = i8 >> 2, hsel = (i8 >> 1) & 1, p0 = 16 * (i8 & 1);
    constexpr int NJ = MH + MH / 4;
    int job = (qmul != 1.0f ? MH : 0) + F.gw; if (job >= NJ) return;
    v4u w0, w1; { const bf16* p = rope_ptr(Z, job, F.lane); w0 = *(const v4u*)p; w1 = *(const v4u*)(p + 8); }
    while (job < NJ) {
        const int njob = job + F.NGW; v4u n0, n1;
        { const bf16* p = rope_ptr(Z, njob < NJ ? njob : job, F.lane); n0 = *(const v4u*)p; n1 = *(const v4u*)(p + 8); }
        const bool isq = job < MH;
        const int row = isq ? job : 4 * (job - MH) + (F.lane >> 4);
        bf16* p = rope_ptr(Z, job, F.lane);
        float x[16]; { float a[8], b[8]; unpack8(w0, a); unpack8(w1, b);
#pragma unroll
            for (int e = 0; e < 8; ++e) { x[e] = a[e]; x[8 + e] = b[e]; } }
        float ss = 0.f;
#pragma unroll
        for (int e = 0; e < 16; ++e) ss += x[e] * x[e];
        ss += dpp_xor1(ss); ss += dpp_xor2(ss); ss += dpp_hmirror(ss);
        const float rs = __builtin_amdgcn_rsqf(ss * (1.0f / 128) + EPS);
        const int t = row % S; const int pos = axis ? (t & 63) : (t >> 6);
        const f32x4* tp = (const f32x4*)(tab + (size_t)(pos * 32 + p0) * 2);
        float out[16];
#pragma unroll
        for (int e2 = 0; e2 < 8; ++e2) {
            const f32x4 cs = tp[e2];
#pragma unroll
            for (int q = 0; q < 2; ++q) { const int e = 2 * e2 + q; const float xn = x[e] * rs * (isq ? gq[e] * qmul : gk[e]); const float pr = dpp_xor2(xn);
                const float c = q ? cs.z : cs.x, s = q ? cs.w : cs.y; out[e] = hsel ? (xn * c + pr * s) : (xn * c - pr * s); }
        }
        v4u o0, o1; o0.x = pk2(out[0], out[1]); o0.y = pk2(out[2], out[3]); o0.z = pk2(out[4], out[5]); o0.w = pk2(out[6], out[7]);
        o1.x = pk2(out[8], out[9]); o1.y = pk2(out[10], out[11]); o1.z = pk2(out[12], out[13]); o1.w = pk2(out[14], out[15]);
        *(v4u*)p = o0; *(v4u*)(p + 8) = o1;
        w0 = n0; w1 = n1; job = njob;
    }
}

template <int DIR>
__device__ __forceinline__ void rnn_tile_scan(float (&a)[16], float (&u)[16], int hi, float& carry, float& aprod) {
    const int he = DIR ? 1 - hi : hi;
    float Ag[4], Bg[4];
#pragma unroll
    for (int g = 0; g < 4; ++g) { float P = 1.f, H = 0.f;
#pragma unroll
        for (int j = 0; j < 4; ++j) { const int r = DIR ? 15 - (4 * g + j) : 4 * g + j; H = a[r] * H + u[r]; P = P * a[r]; u[r] = H; a[r] = P; }
        Ag[g] = P; Bg[g] = H; }
    float c = carry, ap = aprod;
#pragma unroll
    for (int g = 0; g < 4; ++g) {
        const auto sA = __builtin_amdgcn_permlane32_swap(__float_as_uint(Ag[g]), __float_as_uint(Ag[g]), false, false); const auto sB = __builtin_amdgcn_permlane32_swap(__float_as_uint(Bg[g]), __float_as_uint(Bg[g]), false, false);
        const float A0 = __uint_as_float(sA[DIR]), B0 = __uint_as_float(sB[DIR]), A1 = __uint_as_float(sA[1 - DIR]), B1 = __uint_as_float(sB[1 - DIR]);
        const float c0 = c; c = A0 * c + B0; const float c1 = c; c = A1 * c + B1;
        const float ap0 = ap, ap1 = ap * A0; ap = ap1 * A1;
        const float cown = he ? c1 : c0, apown = he ? ap1 : ap0;
#pragma unroll
        for (int j = 0; j < 4; ++j) { const int r = DIR ? 15 - (4 * g + j) : 4 * g + j; u[r] = u[r] + a[r] * cown; a[r] = a[r] * apown; }
    }
    carry = c; aprod = ap;
}
__device__ __forceinline__ void rnn_store_tile(const float (&x)[16], bf16* base  , int hi, int odd) {
#pragma unroll
    for (int i = 0; i < 8; ++i) { const int r0 = 2 * i, r1 = 2 * i + 1;
        const float recv = dpp_xor1(vsel(odd, x[r0], x[r1]));
        const unsigned w = pk2(vsel(odd, recv, x[r0]), vsel(odd, x[r1], recv));
        const int row = odd ? ((r1 & 3) + 8 * (r1 >> 2) + 4 * hi) : ((r0 & 3) + 8 * (r0 >> 2) + 4 * hi);
        *(unsigned*)(base + (size_t)row * RNNW) = w; }
}
__device__ __forceinline__ void rnn_pass(const Frame& F, ArgP A, int S) {
    LAS unsigned char* img = F.lds + RING_OFF;
    const int dir = F.wave >> 2, cq = F.wave & 3, n = F.lane & 31, hi = F.lane >> 5;
    const bf16* Z = wsp<bf16>(A, WS_Z);
    int cur_blk = -1;
    bf16x8 Wa[8], Wx[8]; float ba = 0.f, bx = 0.f, cneg = 0.f;
    for (int unit = F.bid; unit < NCHUNK * 8; unit += F.G) {
        const int blk = unit & 7, chunk = unit >> 3, zr0 = chunk * LC;
        const int ch = blk * 128 + cq * 32 + n;
        if (blk != cur_blk) {
            cur_blk = blk;
            const float* wa = inp(A, dir ? 18 : 13) + ((size_t)blk * 128 + 8 * hi) * 128 + cq * 32 + n; const float* wx = inp(A, dir ? 20 : 15) + ((size_t)blk * 128 + 8 * hi) * 128 + cq * 32 + n;
#pragma unroll
            for (int ks = 0; ks < 8; ++ks) { float va[8], vx[8];
#pragma unroll
                for (int j = 0; j < 8; ++j) { va[j] = wa[(16 * ks + j) * 128]; vx[j] = wx[(16 * ks + j) * 128]; }
                v4u pa, px; pa.x = pk2(va[0], va[1]); pa.y = pk2(va[2], va[3]); pa.z = pk2(va[4], va[5]); pa.w = pk2(va[6], va[7]);
                px.x = pk2(vx[0], vx[1]); px.y = pk2(vx[2], vx[3]); px.z = pk2(vx[4], vx[5]); px.w = pk2(vx[6], vx[7]);
                Wa[ks] = __builtin_bit_cast(bf16x8, pa); Wx[ks] = __builtin_bit_cast(bf16x8, px); }
            ba = -1.4426950408889634f * inp(A, dir ? 19 : 14)[ch]; bx = -1.4426950408889634f * inp(A, dir ? 21 : 16)[ch];
            cneg = -8.0f * 1.4426950408889634f * log1pf(expf(-inp(A, dir ? 22 : 17)[ch]));
        }
        __syncthreads();
        {
            const int ch4 = (F.tid & 31) * 4;
            const int sq0 = (zr0 / S) * S, sq1 = sq0 + S;
            const float* wcv = inp(A, 11) + blk * 128 + ch4; const f32x4 bc = *(const f32x4*)(inp(A, 12) + blk * 128 + ch4);
            const f32x4 w0 = *(const f32x4*)(wcv), w1 = *(const f32x4*)(wcv + RNNW), w2 = *(const f32x4*)(wcv + 2 * RNNW), w3 = *(const f32x4*)(wcv + 3 * RNNW);
            for (int hh = 0; hh < 2; ++hh) {
                const int r0 = ((F.tid >> 5) + 16 * hh) * 8;
                v2u xin[11];
#pragma unroll
                for (int i = 0; i < 11; ++i) { const int row = zr0 + r0 - 2 + i; const bool ok = row >= sq0 && row < sq1;
                    xin[i] = ok ? __builtin_nontemporal_load((const v2u*)(Z + (size_t)row * INW + ZXR + blk * 128 + ch4)) : (v2u){0u, 0u}; }
#pragma unroll
                for (int rr = 0; rr < 8; ++rr) {
                    const f32x4 x0 = (f32x4){bflo(xin[rr].x), bfhi(xin[rr].x), bflo(xin[rr].y), bfhi(xin[rr].y)}, x1 = (f32x4){bflo(xin[rr + 1].x), bfhi(xin[rr + 1].x), bflo(xin[rr + 1].y), bfhi(xin[rr + 1].y)};
                    const f32x4 x2 = (f32x4){bflo(xin[rr + 2].x), bfhi(xin[rr + 2].x), bflo(xin[rr + 2].y), bfhi(xin[rr + 2].y)}, x3 = (f32x4){bflo(xin[rr + 3].x), bfhi(xin[rr + 3].x), bflo(xin[rr + 3].y), bfhi(xin[rr + 3].y)};
                    const f32x4 xc = bc + ((w0 * x0 + w1 * x1) + (w2 * x2 + w3 * x3));
                    v2u o; o.x = pk2(xc.x, xc.y); o.y = pk2(xc.z, xc.w);
                    const int row = r0 + rr; *(LAS v2u*)(img + row * 256 + ((ch4 * 2) ^ ((row & 7) << 4))) = o; }
            }
        }
        __syncthreads();
        float carry = 0.f, aprod = 1.f;
        bf16* HLo = wsp<bf16>(A, dir ? WS_HLB : WS_HLF) + (size_t)zr0 * RNNW + (ch & ~1); bf16* PRo = wsp<bf16>(A, dir ? WS_PRB : WS_PRF) + (size_t)zr0 * RNNW + (ch & ~1);
        for (int it = 0; it < 8; ++it) {
            const int rt = dir ? 7 - it : it;
            f32x16 ca = {}, cx = {};
#pragma unroll
            for (int ks = 0; ks < 8; ++ks) { const int row = 32 * rt + n; const bf16x8 Af = *(const LAS bf16x8*)(img + row * 256 + ((32 * ks + 16 * hi) ^ ((row & 7) << 4)));
                ca = __builtin_amdgcn_mfma_f32_32x32x16_bf16(Af, Wa[ks], ca, 0, 0, 0); cx = __builtin_amdgcn_mfma_f32_32x32x16_bf16(Af, Wx[ks], cx, 0, 0, 0); }
            float a[16], u[16];
#pragma unroll
            for (int r = 0; r < 16; ++r) { const int row = 32 * rt + (r & 3) + 8 * (r >> 2) + 4 * hi;
                const float xcv = __uint_as_float((unsigned)(*(const LAS unsigned short*)(img + row * 256 + (((cq * 32 + n) * 2) ^ ((row & 7) << 4)))) << 16);
                const float rg_ = __builtin_amdgcn_rcpf(1.0f + __builtin_amdgcn_exp2f(fmaf(ca[r], -1.4426950408889634f, ba)));
                const float ig = __builtin_amdgcn_rcpf(1.0f + __builtin_amdgcn_exp2f(fmaf(cx[r], -1.4426950408889634f, bx)));
                const float av = __builtin_amdgcn_exp2f(cneg * rg_);
                a[r] = av; u[r] = __builtin_amdgcn_sqrtf(fmaxf(fmaf(-av, av, 1.0f), 0.f)) * (ig * xcv); }
            if (dir == 0) rnn_tile_scan<0>(a, u, hi, carry, aprod); else rnn_tile_scan<1>(a, u, hi, carry, aprod);
            rnn_store_tile(u, HLo + (size_t)(32 * rt) * RNNW, hi, n & 1);
            rnn_store_tile(a, PRo + (size_t)(32 * rt) * RNNW, hi, n & 1);
        }
        if (hi == 0) wsp<f32x2>(A, WS_SUM)[((size_t)chunk * 2 + dir) * RNNW + ch] = (f32x2){aprod, carry};
    }
}
__device__ __forceinline__ void rnn_carry(const Frame& F, const f32x2* SUM, float* CIN, int nseq, int cps) {
    const int gid = F.bid * (NWAVES * 64) + F.tid;
    if (gid >= nseq * 2 * RNNW) return;
    const int s = gid / (2 * RNNW), rem = gid % (2 * RNNW), dir = rem / RNNW, ch = rem % RNNW;
    float st = 0.f;
#pragma unroll 8
    for (int i = 0; i < cps; ++i) { const int c = s * cps + (dir ? cps - 1 - i : i); const size_t o = ((size_t)c * 2 + dir) * RNNW + ch;
        CIN[o] = st; const f32x2 ab = SUM[o]; st = ab.x * st + ab.y; }
}

constexpr int PH_PER_HALF = 12, N_PHASES = 1 + 2 * PH_PER_HALF;
#define IN(k) (LO <= (k) && (k) < HI)
#define SEAM(k) do { if constexpr (LO <= (k) && (k) + 1 < HI) xcd_barrier(bar); } while (0)
#ifndef GEMM_ALIGN
#define GEMM_ALIGN true
#endif
#ifndef GEMM_SP2
#define GEMM_SP2 true
#endif
#define GEMM_SITE(EPI, Aoff, Boff, N_, K_, Ooff, ldo, RSP) do { Frame F = mkframe(lds, bar.wv); ArgP A = argp(); \
        pg8::Gemm g{wsp<bf16>(A, Aoff), wsp<bf16>(A, Boff), MH, N_, K_}; pg8::StaticOrder So; So.init(MH, N_, F.G, F.bid); \
        EPI E{wsp<bf16>(A, Ooff), ldo, RSP}; pg8::gemm_phase<EPI, pg8::StaticOrder, GEMM_ALIGN, GEMM_SP2>(F.lds + RING_OFF, g, So, E, F.tid); } while (0)

template <int H, int LO, int HI>
__device__ __forceinline__ void trunk(unsigned char* lds, const XcdBarrier& bar) {
    constexpr int pb = 1 + H * PH_PER_HALF;
    constexpr int S = H ? 16384 : 4096;
    constexpr size_t xoff = (size_t)H * MH * DM;
    if constexpr (IN(pb + 0)) GEMM_SITE(pg8::EpiSwiglu, WS_XN, WS_WGU1, NGU, DM, WS_H, DFF, wsp<float>(A, WS_RS));
    SEAM(pb + 0);
    if constexpr (IN(pb + 1)) GEMM_SITE(pg8::EpiBf16, WS_H, WS_WD1, DM, DFF, WS_Y, DM, nullptr);
    SEAM(pb + 1);
    if constexpr (IN(pb + 2)) { Frame F = mkframe(lds, bar.wv); ArgP A = argp();
        t_rows<false, false, false>(F, nullptr, wsp<bf16>(A, WS_Y), 0.5f, inp(A, 6), nullptr, wsp<bf16>(A, WS_XN), wsp<float>(A, WS_RS), nullptr, MH); }
    SEAM(pb + 2);
    if constexpr (IN(pb + 3)) GEMM_SITE(pg8::EpiBf16, WS_XN, WS_WIN, INW, DM, WS_Z, INW, wsp<float>(A, WS_RS));
    SEAM(pb + 3);
    if constexpr (IN(pb + 4)) {
        { Frame F = mkframe(lds, bar.wv); ArgP A = argp(); rope_rows(F, wsp<bf16>(A, WS_Z), inp(A, 9), inp(A, 10), wsp<float>(A, WS_ROPE), S); }
        { Frame F = mkframe(lds, bar.wv); ArgP A = argp(); rnn_pass(F, A, S); }
        __syncthreads();
    }
    SEAM(pb + 4);
    if constexpr (IN(pb + 5)) {
        { Frame F = mkframe(lds, bar.wv); ArgP A = argp(); rnn_carry(F, wsp<f32x2>(A, WS_SUM), wsp<float>(A, WS_CIN), MH / S, S / LC); }
        Frame F = mkframe(lds, bar.wv); ArgP A = argp();
        const bf16* Zb = wsp<bf16>(A, WS_Z);
        const float mfix = attn_bound(inp(A, 9), inp(A, 10), F.lane); const bool fixm = mfix <= ATT_FIX_MAX;
#define ATT_LOOP(FIX) do { Frame F2 = mkframe<(FIX) ? 1 : 2>(lds, bar.wv); ArgP A2 = argp(); const bf16* Zb2 = wsp<bf16>(A2, WS_Z); const int x = F2.bid & 7, rk = F2.bid >> 3; constexpr int nqb = S / 256, UG = 4 * nqb; \
        for (int idx = F2.bid; idx < 1024; idx += F2.G) { int id = idx; if (F2.G == 256) { const int t = (idx - F2.bid) / 256; id = x * 128 + t * 32 + rk; }     \
            const int grp = id / UG, uu = id % UG, b = grp >> 1, kvh = grp & 1, head = kvh * 4 + uu / nqb, qb = uu % nqb; \
            const bf16* zb = Zb2 + (size_t)b * S * INW; bf16* qp = (bf16*)zb + (size_t)qb * 256 * INW + ZQ + head * 128; \
            if constexpr ((FIX) && ATT_MFMA16) att::attn_unit16<S / 64>(qp, zb + ZK + kvh * 128, zb + ZV + kvh * 128, qp, (char*)lds + RING_OFF, F2.lds + RING_OFF, F2.tid, inp(A2, 9), wsp<float>(A2, WS_ROPE), qb * 256, att::SCALE * 1.4426950408889634f); \
            else att::attn_unit<FIX, S / 64>(qp, zb + ZK + kvh * 128, zb + ZV + kvh * 128, qp, S, (char*)lds + RING_OFF, F2.lds + RING_OFF, F2.tid, mfix, inp(A2, 9), wsp<float>(A2, WS_ROPE), qb * 256, (FIX) ? att::SCALE * 1.4426950408889634f : 1.0f); } } while (0)
        if (fixm) ATT_LOOP(true); else ATT_LOOP(false);
#undef ATT_LOOP
    }
    SEAM(pb + 5);
    if constexpr (IN(pb + 6)) { Frame F = mkframe(lds, bar.wv); ArgP A = argp();
        mix_rows(F, wsp<bf16>(A, WS_Z), wsp<bf16>(A, WS_HLF), wsp<bf16>(A, WS_PRF), wsp<bf16>(A, WS_HLB), wsp<bf16>(A, WS_PRB), wsp<float>(A, WS_CIN), inp(A, 23), inp(A, 24), wsp<bf16>(A, WS_MIX)); }
    SEAM(pb + 6);
    if constexpr (IN(pb + 7)) GEMM_SITE(pg8::EpiBf16, WS_MIX, WS_WOUT, DM, DM, WS_Y, DM, nullptr);
    SEAM(pb + 7);
    if constexpr (IN(pb + 8)) { Frame F = mkframe(lds, bar.wv); ArgP A = argp();
        t_rows<false, false, false>(F, nullptr, wsp<bf16>(A, WS_Y), 1.0f, inp(A, 26), nullptr, wsp<bf16>(A, WS_XN), wsp<float>(A, WS_RS), nullptr, MH); }
    SEAM(pb + 8);
    if constexpr (IN(pb + 9)) GEMM_SITE(pg8::EpiSwiglu, WS_XN, WS_WGU2, NGU, DM, WS_H, DFF, wsp<float>(A, WS_RS));
    SEAM(pb + 9);
    if constexpr (IN(pb + 10)) GEMM_SITE(pg8::EpiBf16, WS_H, WS_WD2, DM, DFF, WS_Y, DM, nullptr);
    SEAM(pb + 10);
    if constexpr (IN(pb + 11)) { Frame F = mkframe(lds, bar.wv); ArgP A = argp();
        t_rows<false, true, H == 0>(F, nullptr, wsp<bf16>(A, WS_Y), 0.5f, inp(A, 31), outp(A) + xoff, wsp<bf16>(A, WS_XN), wsp<float>(A, WS_RS), H == 0 ? inp(A, 1) : nullptr, MH); }
    if constexpr (H == 0) SEAM(pb + 11);
}

template <int LO, int HI>
__global__ void __launch_bounds__(NWAVES * 64, 2) hymba_fwd(Args args_unused) {
    extern __shared__ __attribute__((aligned(16))) unsigned char lds[];
    {   LAS unsigned char* l = (LAS unsigned char*)lds;
        for (int u = threadIdx.x; u < (LDS_BYTES - LDSCTL_OFF) / 4; u += NWAVES * 64) ((LAS unsigned*)(l + LDSCTL_OFF))[u] = 0u; }
    __syncthreads();
    int wv0 = __builtin_amdgcn_readfirstlane((int)threadIdx.x >> 6); asm volatile("" : "+s"(wv0));
    XcdBarrier bar; bar.bar = nullptr; bar.x = 0; bar.st = nullptr; bar.wv = wv0;
    if constexpr (HI - LO > 1) { ArgP A = argp(); bar = xcd_barrier_post(wsp<unsigned>(A, WS_CTL) + CW_BAR, (volatile LAS unsigned*)((LAS unsigned char*)lds + MISC_OFF) + 8, wv0); }

    if constexpr (IN(0)) {
        Frame F = mkframe(lds, bar.wv); ArgP A = argp();
        LAS float* scr = (LAS float*)(F.lds + RING_OFF + F.wave * 16384);
        constexpr int I_GU = (DM / 64) * (DFF / 32), I_D = (DFF / 64) * (DM / 32), I_IN = (DM / 64) * (INW / 32), I_O = (DM / 64) * (DM / 32);
        constexpr int NITEMS = 4 * I_GU + 2 * I_D + I_IN + I_O;
        for (int it = F.gw; it < NITEMS; it += F.NGW) {
            int r = it;
            if (r < I_GU) { conv_item(inp(A, 3), DM, DFF, wsp<bf16>(A, WS_WGU1), 1, r, scr, F.lane, inp(A, 2)); continue; } r -= I_GU;
            if (r < I_GU) { conv_item(inp(A, 4), DM, DFF, wsp<bf16>(A, WS_WGU1), 2, r, scr, F.lane, inp(A, 2)); continue; } r -= I_GU;
            if (r < I_D)  { conv_item(inp(A, 5), DFF, DM, wsp<bf16>(A, WS_WD1), 0, r, scr, F.lane); continue; } r -= I_D;
            if (r < I_IN) { conv_item(inp(A, 8), DM, INW, wsp<bf16>(A, WS_WIN), 0, r, scr, F.lane, inp(A, 7)); continue; } r -= I_IN;
            if (r < I_O)  { conv_item(inp(A, 25), DM, DM, wsp<bf16>(A, WS_WOUT), 0, r, scr, F.lane); continue; } r -= I_O;
            if (r < I_GU) { conv_item(inp(A, 28), DM, DFF, wsp<bf16>(A, WS_WGU2), 1, r, scr, F.lane, inp(A, 27)); continue; } r -= I_GU;
            if (r < I_GU) { conv_item(inp(A, 29), DM, DFF, wsp<bf16>(A, WS_WGU2), 2, r, scr, F.lane, inp(A, 27)); continue; } r -= I_GU;
            conv_item(inp(A, 30), DFF, DM, wsp<bf16>(A, WS_WD2), 0, r, scr, F.lane);
        }
        rope_table(F, wsp<float>(A, WS_ROPE));
        pre_rows(F, inp(A, 0), wsp<bf16>(A, WS_XN), wsp<float>(A, WS_RS), MH);
    }
    SEAM(0);
    trunk<0, LO, HI>(lds, bar);
    trunk<1, LO, HI>(lds, bar);
}
#undef IN
#undef SEAM

template <int LO, int HI> static bool launch_range(int grid, hipStream_t stream, const Args& a) {
    static int ok = 0;
    if (ok == 0) { ok = (hipFuncSetAttribute((const void*)hymba_fwd<LO, HI>, hipFuncAttributeMaxDynamicSharedMemorySize, LDS_BYTES) == hipSuccess) ? 1 : -1;
        if (ok < 0) fprintf(stderr, "kernel_launch: hipFuncSetAttribute failed for phases [%d, %d)\n", LO, HI); }
    if (ok < 0) return false;
    hipLaunchKernelGGL((hymba_fwd<LO, HI>), dim3(grid), dim3(NWAVES * 64), LDS_BYTES, stream, a);
    return true;
}
#if MK_PER_PHASE
template <int P> static void launch_from(int grid, hipStream_t stream, const Args& a) {
    if constexpr (P < N_PHASES) { launch_range<P, P + 1>(grid, stream, a); launch_from<P + 1>(grid, stream, a); }
}
#endif
extern "C" void kernel_launch(void* const* d_in, const int* in_sizes, int n_in, void* d_out, int out_size, void* d_ws, size_t ws_size, hipStream_t stream) {
    static int grid = 0;
    if (grid == 0) {
        if (n_in != 32 || in_sizes[0] != MH * DM || in_sizes[1] != MH * DM || out_size != 2 * MH * DM || ws_size < WS_END) {
            fprintf(stderr, "kernel_launch: unexpected shapes (n_in %d, out %d, ws %zu); nothing launched\n", n_in, out_size, ws_size); grid = -1; return; }
        int dev = 0, cus = 0;
        if (hipGetDevice(&dev) != hipSuccess || hipDeviceGetAttribute(&cus, hipDeviceAttributeMultiprocessorCount, dev) != hipSuccess) { grid = -1; return; }
        int per_cu = 0;
#if MK_PER_PHASE
        per_cu = 1;
#else
        if (hipFuncSetAttribute((const void*)hymba_fwd<0, N_PHASES>, hipFuncAttributeMaxDynamicSharedMemorySize, LDS_BYTES) != hipSuccess ||
            hipOccupancyMaxActiveBlocksPerMultiprocessor(&per_cu, (const void*)hymba_fwd<0, N_PHASES>, NWAVES * 64, LDS_BYTES) != hipSuccess || per_cu < 1) {
            fprintf(stderr, "kernel_launch: the occupancy query reports %d workgroups per CU for this kernel; launching one per CU anyway\n", per_cu); per_cu = 1; }
        (void)hipGetLastError();
#endif
        grid = cus * (per_cu < 1 ? per_cu : 1);
    }
    if (grid < 0) return;
    if (hipMemsetAsync((char*)d_ws + WS_CTL, 0, CTL_ZERO_BYTES, stream) != hipSuccess) return;
    Args a{};
    for (int i = 0; i < 32; ++i) a.in[i] = (unsigned long long)(uintptr_t)d_in[i];
    a.out = (unsigned long long)(uintptr_t)d_out; a.ws = (unsigned long long)(uintptr_t)d_ws;
    a.ph_lo = 0; a.ph_hi = N_PHASES;
#if MK_PER_PHASE
    launch_from<0>(grid, stream, a);
#else
    launch_range<0, N_PHASES>(grid, stream, a);
#endif
    const hipError_t le = hipPeekAtLastError();
    if (le != hipSuccess) fprintf(stderr, "kernel_launch: launch failed: %s\n", hipGetErrorName(le));
}
```
